# Optimizing an MI355X kernel written in HIP

```python
import jax, jax.numpy as jnp
from jax import lax
import numpy as np

D_MODEL = 1024
BATCH = 8
SEQ = 4096
DEPTH = 4

HEAD_DIM = 64
MIX_WIDTH = D_MODEL
MLA_HEADS = MIX_WIDTH // 2 // HEAD_DIM
MLA_WIDTH = MLA_HEADS * HEAD_DIM
NOPE_DIM = HEAD_DIM
ROPE_DIM = HEAD_DIM // 2
V_DIM = HEAD_DIM
Q_RANK = 3 * D_MODEL // 8
KV_RANK = 4 * HEAD_DIM
ROPE_THETA = 10000.0
Q_BLOCK = 128
SG_GROUPS = MIX_WIDTH // 4 // HEAD_DIM
SG_WIDTH = SG_GROUPS * HEAD_DIM
CHUNK = 128
CV_GROUPS = MIX_WIDTH // 4 // HEAD_DIM
CV_WIDTH = CV_GROUPS * HEAD_DIM
CONV_WIDTH = 3
D_FF = ((8 * D_MODEL + 3 * 256 - 1) // (3 * 256)) * 256
EPS = 1e-6
OFF_CQ = 0
OFF_CKV = OFF_CQ + Q_RANK
OFF_KR = OFF_CKV + KV_RANK
OFF_SG = OFF_KR + ROPE_DIM
OFF_CV = OFF_SG + 2 * SG_WIDTH
IN_WIDTH = OFF_CV + 3 * CV_WIDTH

kernel_name = "hybrid_mla_sgu_shortconv_sandwich"


def rms_norm(x, g):
    xf = x.astype(jnp.float32)
    y = xf * lax.rsqrt(jnp.mean(xf * xf, axis=-1, keepdims=True) + EPS)
    return y.astype(x.dtype) * g


def group_layer_norm(x, g, b, groups):
    shp = x.shape
    xf = x.astype(jnp.float32).reshape(shp[:-1] + (groups, shp[-1] // groups))
    mu = jnp.mean(xf, axis=-1, keepdims=True)
    var = jnp.mean(jnp.square(xf - mu), axis=-1, keepdims=True)
    y = ((xf - mu) * lax.rsqrt(var + EPS)).reshape(shp)
    return y.astype(x.dtype) * g + b


def rope_tables(positions):
    inv_freq = 1.0 / (ROPE_THETA ** (jnp.arange(0, ROPE_DIM // 2, dtype=jnp.float32) / (ROPE_DIM // 2)))
    ang = positions.astype(jnp.float32)[..., None] * inv_freq
    return jnp.cos(ang), jnp.sin(ang)


def apply_rope(t, cos, sin):
    tf = t.astype(jnp.float32)
    t1, t2 = jnp.split(tf, 2, axis=-1)
    return jnp.concatenate([t1 * cos - t2 * sin, t2 * cos + t1 * sin], axis=-1).astype(t.dtype)


def causal_latent_attention(q_nope, q_rope, k_nope, k_rope, v):
    b, s, h, _ = q_nope.shape
    nb = s // Q_BLOCK
    scale = (NOPE_DIM + ROPE_DIM) ** -0.5
    kpos = jnp.arange(s)

    def to_blocks(t):
        return jnp.moveaxis(t.reshape((b, nb, Q_BLOCK) + t.shape[2:]), 1, 0)

    def one_block(args):
        qn, qr, i = args
        sc = (jnp.einsum('bqhd,bkhd->bhqk', qn, k_nope)
              + jnp.einsum('bqhd,bkd->bhqk', qr, k_rope)).astype(jnp.float32) * scale
        qpos = i * Q_BLOCK + jnp.arange(Q_BLOCK)
        mask = kpos[None, :] <= qpos[:, None]
        sc = jnp.where(mask, sc, jnp.finfo(jnp.float32).min)
        p = jax.nn.softmax(sc, axis=-1).astype(v.dtype)
        return jnp.einsum('bhqk,bkhd->bqhd', p, v)

    out = lax.map(one_block, (to_blocks(q_nope), to_blocks(q_rope), jnp.arange(nb)))
    return jnp.moveaxis(out, 0, 1).reshape(b, s, h * V_DIM)


def mla_branch(z, cos, sin, q_norm_g, w_uq, kv_norm_g, w_ukv):
    b, s, _ = z.shape
    c_q = rms_norm(z[..., OFF_CQ:OFF_CKV], q_norm_g)
    q = (c_q @ w_uq).reshape(b, s, MLA_HEADS, NOPE_DIM + ROPE_DIM)
    q_nope = q[..., :NOPE_DIM]
    q_rope = apply_rope(q[..., NOPE_DIM:], cos[:, :, None, :], sin[:, :, None, :])
    c_kv = rms_norm(z[..., OFF_CKV:OFF_KR], kv_norm_g)
    kv = (c_kv @ w_ukv).reshape(b, s, MLA_HEADS, NOPE_DIM + V_DIM)
    k_nope, v = kv[..., :NOPE_DIM], kv[..., NOPE_DIM:]
    k_rope = apply_rope(z[..., OFF_KR:OFF_SG], cos, sin)
    return causal_latent_attention(q_nope, q_rope, k_nope, k_rope, v)


def sgu_branch(z, sg_ln_g, sg_ln_b, w_sp, b_sp):
    b, s, _ = z.shape
    uv = jax.nn.gelu(z[..., OFF_SG:OFF_CV])
    u, v = uv[..., :SG_WIDTH], uv[..., SG_WIDTH:]
    v = group_layer_norm(v, sg_ln_g, sg_ln_b, SG_GROUPS)
    vc = v.reshape(b, s // CHUNK, CHUNK, SG_GROUPS, HEAD_DIM)
    w_causal = w_sp * jnp.tril(jnp.ones((CHUNK, CHUNK), w_sp.dtype))
    mixed = jnp.einsum('gts,bcsge->bctge', w_causal, vc) + jnp.swapaxes(b_sp, 0, 1)[:, :, None]
    return u * mixed.reshape(b, s, SG_WIDTH)


def conv_branch(z, conv_w):
    gate_b = z[..., OFF_CV:OFF_CV + CV_WIDTH]
    gate_c = z[..., OFF_CV + CV_WIDTH:OFF_CV + 2 * CV_WIDTH]
    h = z[..., OFF_CV + 2 * CV_WIDTH:IN_WIDTH]
    y = gate_c * h
    yp = jnp.pad(y, ((0, 0), (CONV_WIDTH - 1, 0), (0, 0)))
    s = y.shape[1]
    conv = yp[:, 0:s] * conv_w[0] + yp[:, 1:s + 1] * conv_w[1] + yp[:, 2:s + 2] * conv_w[2]
    return gate_b * conv


def setup_inputs(seed: int = 0) -> dict:
    key = jax.random.key(seed)
    ks = jax.random.split(key, 24)
    L, D = DEPTH, D_MODEL

    def nrm(k, shape, fan_in):
        return jax.random.normal(k, shape, jnp.float32) * fan_in ** -0.5

    def gain(k, shape):
        return 1.0 + 0.05 * jax.random.normal(k, shape, jnp.float32)

    x = jax.random.normal(ks[0], (BATCH, SEQ, D), jnp.float32)
    offsets = jax.random.randint(ks[1], (BATCH, 1), 0, 1024, dtype=jnp.int32)
    positions = (offsets + jnp.arange(SEQ, dtype=jnp.int32)[None, :]).astype(jnp.int32)
    return {
        "x": x,
        "positions": positions,
        "mix_pre_g": gain(ks[2], (L, D)),
        "mix_post_g": gain(ks[3], (L, D)),
        "ffn_pre_g": gain(ks[4], (L, D)),
        "ffn_post_g": gain(ks[5], (L, D)),
        "w_in": nrm(ks[6], (L, D, IN_WIDTH), D),
        "q_norm_g": gain(ks[7], (L, Q_RANK)),
        "w_uq": nrm(ks[8], (L, Q_RANK, MLA_HEADS * (NOPE_DIM + ROPE_DIM)), Q_RANK),
        "kv_norm_g": gain(ks[9], (L, KV_RANK)),
        "w_ukv": nrm(ks[10], (L, KV_RANK, MLA_HEADS * (NOPE_DIM + V_DIM)), KV_RANK),
        "sg_ln_g": gain(ks[11], (L, SG_WIDTH)),
        "sg_ln_b": 0.02 * jax.random.normal(ks[12], (L, SG_WIDTH), jnp.float32),
        "w_sp": nrm(ks[13], (L, SG_GROUPS, CHUNK, CHUNK), CHUNK),
        "b_sp": gain(ks[14], (L, SG_GROUPS, CHUNK)),
        "conv_w": nrm(ks[15], (L, CONV_WIDTH, CV_WIDTH), CONV_WIDTH),
        "out_norm_g": gain(ks[16], (L, MIX_WIDTH)),
        "w_out": nrm(ks[17], (L, MIX_WIDTH, D), MIX_WIDTH),
        "w_gate": nrm(ks[18], (L, D, D_FF), D),
        "w_up": nrm(ks[19], (L, D, D_FF), D),
        "w_down": nrm(ks[20], (L, D_FF, D), D_FF),
    }


def reference(x, positions, mix_pre_g, mix_post_g, ffn_pre_g, ffn_post_g, w_in, q_norm_g, w_uq,
              kv_norm_g, w_ukv, sg_ln_g, sg_ln_b, w_sp, b_sp, conv_w, out_norm_g, w_out,
              w_gate, w_up, w_down):
    cos, sin = rope_tables(positions)
    a_end = MLA_WIDTH
    s_end = MLA_WIDTH + SG_WIDTH
    for l in range(DEPTH):
        h = rms_norm(x, mix_pre_g[l])
        z = h @ w_in[l]
        y_a = mla_branch(z, cos, sin, q_norm_g[l], w_uq[l], kv_norm_g[l], w_ukv[l])
        y_b = sgu_branch(z, sg_ln_g[l], sg_ln_b[l], w_sp[l], b_sp[l])
        y_c = conv_branch(z, conv_w[l])
        g = out_norm_g[l]
        mix = jnp.concatenate([rms_norm(y_a, g[:a_end]),
                               rms_norm(y_b, g[a_end:s_end]),
                               rms_norm(y_c, g[s_end:])], axis=-1)
        x = x + rms_norm(mix @ w_out[l], mix_post_g[l])
        h = rms_norm(x, ffn_pre_g[l])
        f = (jax.nn.silu(h @ w_gate[l]) * (h @ w_up[l])) @ w_down[l]
        x = x + rms_norm(f, ffn_post_g[l])
    return x
```

```cpp
#include <hip/hip_runtime.h>
#include <hip/hip_cooperative_groups.h>
#include <cstdio>
#include <cstdint>
#include <cmath>
namespace cg = cooperative_groups;
namespace pg8 {
#define PG8_LAS __attribute__((address_space(3)))
typedef unsigned short bf16_t;
typedef short bf16x8 __attribute__((ext_vector_type(8)));
typedef float f32x4 __attribute__((ext_vector_type(4)));
typedef unsigned u32x4 __attribute__((ext_vector_type(4)));
constexpr int BM = 256, BK = 64, HALF = 128, HTB = HALF * BK * 2  , STAGE_BYTES = 8 * HTB, NXCD = 8, WGM = 8;

__host__ __device__ __forceinline__ int lds_byte(int r, int c) { const int st = (r >> 4) * 2 + (c >> 5), rr = r & 15, cc = c & 31, ob = rr * 64 + cc * 2; return st * 1024 + (ob ^ (((ob >> 9) & 1) << 5)); }
__host__ __device__ __forceinline__ void stage_rc(int b, int& R, int& C) { const int st = b / 1024, sb = b % 1024, swz = sb ^ (((sb >> 9) & 1) << 5); R = (st >> 1) * 16 + swz / 64; C = (st & 1) * 32 + (swz % 64) / 2; }
__host__ __device__ __forceinline__ int perm32(int rho) { const int n = rho >> 4, i = rho & 15; return 8 * (i >> 2) + 4 * n + (i & 3); }

struct Unit { int pm, pn; };
struct Gemm { const bf16_t* A; const bf16_t* Bt; int M, N, K; };

struct StaticOrder {
    int nM, nN, nwg, G, c;
    __host__ __device__ void init(int M, int N, int G_, int c_) { nM = M / BM; nN = N / BM; nwg = nM * nN; G = G_; c = c_; }
    __host__ __device__ bool next(int i, Unit& u) const {
        const long L = (long)i * G + c; if (L >= nwg) return false;
        int wgid = (int)L; { const int q = nwg / NXCD, r = nwg % NXCD, xcd = wgid % NXCD, off = wgid / NXCD; wgid = (xcd < r ? xcd * (q + 1) : r * (q + 1) + (xcd - r) * q) + off; }
        const int nig = WGM * nN, gid = wgid / nig, fm = gid * WGM, gsz = (nM - fm) < WGM ? (nM - fm) : WGM;
        u.pm = fm + ((wgid % nig) % gsz); u.pn = (wgid % nig) / gsz; return true;
    }
    __device__ __forceinline__ void a_ready(const Unit&) const {}
    __device__ __forceinline__ void done(const Unit&) const {}
};

template <class Epi, class Sched, bool ALIGN_EPI = false, bool SP2 = false>
__device__ __forceinline__ void gemm_phase(PG8_LAS unsigned char* lds, const Gemm g, const Sched& S, const Epi& E) {
    int tid_ = threadIdx.x; asm volatile("" : "+v"(tid_));
    const int tid = tid_, wid = __builtin_amdgcn_readfirstlane(tid >> 6), lane = tid & 63, wr = wid >> 2, wc = wid & 3, fr = lane & 15, fq = lane >> 4;
    const int K = g.K, nt = K / BK;
    unsigned voffA[2], voffB[2];
#pragma unroll
    for (int i = 0; i < 2; ++i) { int R, C; stage_rc(tid * 16 + i * 8192, R, C); const int Rb = Epi::PERM ? ((R & ~31) + perm32(R & 31)) : R;
        voffA[i] = (unsigned)(R * K + C) * 2u; voffB[i] = (unsigned)(Rb * K + C) * 2u; }
    const size_t kstep = (size_t)(BK * 2);
    const size_t hstep = (size_t)HALF * K * 2;
    const size_t tstep = 2 * hstep;
    const unsigned ldsw = (unsigned)wid * 1024u;
    const int aoff = lds_byte(wr * 64 + fr, fq * 8), boff = lds_byte(wc * 32 + fr, fq * 8);
#define PG8_SA(b, h) (((b) * 2 + (h)) * HTB)
#define PG8_SB(b, h) ((4 + (b) * 2 + (h)) * HTB)
#define PG8_STAGE(bufoff, gbase, voff) do { _Pragma("unroll") for (int _i = 0; _i < 2; ++_i) \
        __builtin_amdgcn_global_load_lds((const unsigned*)((const char*)(gbase) + (voff)[_i]), (PG8_LAS unsigned*)(lds + (bufoff) + ldsw + _i * 8192), 16, 0, 0); } while (0)
#define PG8_LDA(dst, b, h) do { _Pragma("unroll") for (int m = 0; m < 4; ++m) _Pragma("unroll") for (int k = 0; k < 2; ++k) dst[m][k] = *(const PG8_LAS bf16x8*)(lds + PG8_SA(b, h) + aoff + m * 2048 + k * 1024); } while (0)
#define PG8_LDB(dst, b, h) do { _Pragma("unroll") for (int n = 0; n < 2; ++n) _Pragma("unroll") for (int k = 0; k < 2; ++k) dst[n][k] = *(const PG8_LAS bf16x8*)(lds + PG8_SB(b, h) + boff + n * 2048 + k * 1024); } while (0)
#define PG8_MMA(ai, bj, At, Bt) do { __builtin_amdgcn_s_setprio(1); _Pragma("unroll") for (int m = 0; m < 4; ++m) _Pragma("unroll") for (int n = 0; n < 2; ++n) _Pragma("unroll") for (int k = 0; k < 2; ++k) \
        acc[ai][bj][m][n] = __builtin_amdgcn_mfma_f32_16x16x32_bf16(Bt[n][k], At[m][k], acc[ai][bj][m][n], 0, 0, 0); __builtin_amdgcn_s_setprio(0); } while (0)
#define PG8_WAIT_V(n) asm volatile("s_waitcnt vmcnt(" #n ")" ::: "memory")
#define PG8_WAIT_L(n) asm volatile("s_waitcnt lgkmcnt(" #n ")" ::: "memory")
#define PG8_BAR __builtin_amdgcn_s_barrier()
#define PG8_SCHED __builtin_amdgcn_sched_barrier(0)
    Unit cur, nxt; int ui = 0;
    if (!S.next(0, cur)) return;
    f32x4 acc[2][2][4][2];
#pragma unroll
    for (int a = 0; a < 2; ++a)
#pragma unroll
        for (int b = 0; b < 2; ++b)
#pragma unroll
            for (int m = 0; m < 4; ++m)
#pragma unroll
                for (int n = 0; n < 2; ++n) acc[a][b][m][n] = (f32x4){0.f, 0.f, 0.f, 0.f};
    bf16x8 At[4][2], B0[2][2], B1[2][2];
    const char* cA = (const char*)g.A + (size_t)cur.pm * tstep; const char* cB = (const char*)g.Bt + (size_t)cur.pn * tstep;
    S.a_ready(cur);
    if constexpr (SP2) {
        PG8_STAGE(PG8_SB(0, 0), cB, voffB); PG8_STAGE(PG8_SB(0, 1), cB + hstep, voffB); PG8_STAGE(PG8_SA(0, 0), cA, voffA); PG8_STAGE(PG8_SA(0, 1), cA + hstep, voffA);
        if (wr == 1) PG8_BAR;
        PG8_WAIT_V(2); PG8_BAR;
        PG8_STAGE(PG8_SB(1, 0), cB + kstep, voffB); PG8_STAGE(PG8_SA(1, 0), cA + kstep, voffA); PG8_STAGE(PG8_SB(1, 1), cB + hstep + kstep, voffB);
        PG8_WAIT_V(6); PG8_BAR;
    } else {
        PG8_STAGE(PG8_SB(0, 0), cB, voffB); PG8_STAGE(PG8_SA(0, 0), cA, voffA); PG8_STAGE(PG8_SB(0, 1), cB + hstep, voffB); PG8_STAGE(PG8_SA(0, 1), cA + hstep, voffA);
        if (wr == 1) PG8_BAR;
        PG8_WAIT_V(4); PG8_BAR;
        PG8_STAGE(PG8_SB(1, 0), cB + kstep, voffB); PG8_STAGE(PG8_SA(1, 0), cA + kstep, voffA); PG8_STAGE(PG8_SB(1, 1), cB + hstep + kstep, voffB);
        PG8_WAIT_V(6); PG8_BAR;
    }
    for (;;) {
        const bool has_next = S.next(ui + 1, nxt);
        const char* nA = has_next ? (const char*)g.A + (size_t)nxt.pm * tstep : cA; const char* nB = has_next ? (const char*)g.Bt + (size_t)nxt.pn * tstep : cB;
        for (int t = 0; t < nt; t += 2) {
            const bool last = (t == nt - 2);
            const char* a1 = cA + (size_t)(t + 1) * kstep;
            const char* a2 = last ? nA : cA + (size_t)(t + 2) * kstep; const char* b2 = last ? nB : cB + (size_t)(t + 2) * kstep;
            const char* a3 = a2 + kstep; const char* b3 = b2 + kstep;
            if (last && has_next) S.a_ready(nxt);
            if constexpr (SP2) {
            PG8_LDB(B0, 0, 0); PG8_LDB(B1, 0, 1); PG8_SCHED; PG8_LDA(At, 0, 0); PG8_STAGE(PG8_SA(1, 1), a1 + hstep, voffA);
            PG8_WAIT_V(8); PG8_WAIT_L(0); PG8_BAR; PG8_MMA(0, 0, At, B0); PG8_MMA(0, 1, At, B1); PG8_BAR; PG8_SCHED;
            PG8_LDA(At, 0, 1); PG8_STAGE(PG8_SB(0, 0), b2, voffB); PG8_STAGE(PG8_SB(0, 1), b2 + hstep, voffB); PG8_STAGE(PG8_SA(0, 0), a2, voffA);
            PG8_WAIT_V(8); PG8_WAIT_L(0); PG8_BAR; PG8_MMA(1, 0, At, B0); PG8_MMA(1, 1, At, B1); PG8_BAR; PG8_SCHED;
            PG8_LDB(B0, 1, 0); PG8_LDB(B1, 1, 1); PG8_SCHED; PG8_LDA(At, 1, 0); PG8_STAGE(PG8_SA(0, 1), a2 + hstep, voffA);
            PG8_WAIT_V(8); PG8_WAIT_L(0); PG8_BAR; PG8_MMA(0, 0, At, B0); PG8_MMA(0, 1, At, B1); PG8_BAR; PG8_SCHED;
            PG8_LDA(At, 1, 1); PG8_STAGE(PG8_SB(1, 0), b3, voffB); PG8_STAGE(PG8_SB(1, 1), b3 + hstep, voffB); PG8_STAGE(PG8_SA(1, 0), a3, voffA);
            PG8_WAIT_V(8); PG8_WAIT_L(0); PG8_BAR; PG8_MMA(1, 0, At, B0); PG8_MMA(1, 1, At, B1); PG8_BAR; PG8_SCHED;
            } else {
            PG8_LDB(B0, 0, 0); PG8_SCHED; PG8_LDA(At, 0, 0); PG8_STAGE(PG8_SA(1, 1), a1 + hstep, voffA);
            PG8_WAIT_L(8); PG8_BAR; PG8_WAIT_L(0); PG8_MMA(0, 0, At, B0); PG8_BAR; PG8_SCHED;
            PG8_LDB(B1, 0, 1); PG8_STAGE(PG8_SB(0, 0), b2, voffB);
            PG8_BAR; PG8_WAIT_L(0); PG8_MMA(0, 1, At, B1); PG8_BAR;
            PG8_LDA(At, 0, 1); PG8_STAGE(PG8_SA(0, 0), a2, voffA);
            PG8_BAR; PG8_WAIT_L(0); PG8_MMA(1, 0, At, B0); PG8_BAR; PG8_SCHED;
            PG8_STAGE(PG8_SB(0, 1), b2 + hstep, voffB);
            PG8_WAIT_V(6); PG8_BAR; PG8_MMA(1, 1, At, B1); PG8_BAR;
            PG8_LDB(B0, 1, 0); PG8_SCHED; PG8_LDA(At, 1, 0); PG8_STAGE(PG8_SA(0, 1), a2 + hstep, voffA);
            PG8_WAIT_L(8); PG8_BAR; PG8_WAIT_L(0); PG8_MMA(0, 0, At, B0); PG8_BAR; PG8_SCHED;
            PG8_LDB(B1, 1, 1); PG8_STAGE(PG8_SB(1, 0), b3, voffB);
            PG8_BAR; PG8_WAIT_L(0); PG8_MMA(0, 1, At, B1); PG8_BAR;
            PG8_LDA(At, 1, 1); PG8_STAGE(PG8_SA(1, 0), a3, voffA);
            PG8_BAR; PG8_WAIT_L(0); PG8_MMA(1, 0, At, B0); PG8_BAR; PG8_SCHED;
            PG8_STAGE(PG8_SB(1, 1), b3 + hstep, voffB);
            PG8_WAIT_V(6); PG8_BAR; PG8_MMA(1, 1, At, B1); PG8_BAR;
            }
        }
        if constexpr (ALIGN_EPI) { if (wr == 0) PG8_BAR; }
        if constexpr (!Epi::AFTER_DRAIN) { E(acc, cur, wr, wc, fr, fq); S.done(cur); }
        if (!has_next) break;
#pragma unroll
        for (int a = 0; a < 2; ++a)
#pragma unroll
            for (int b = 0; b < 2; ++b)
#pragma unroll
                for (int m = 0; m < 4; ++m)
#pragma unroll
                    for (int n = 0; n < 2; ++n) acc[a][b][m][n] = (f32x4){0.f, 0.f, 0.f, 0.f};
        cur = nxt; cA = nA; cB = nB; ++ui;
        if constexpr (ALIGN_EPI) { if (wr == 1) PG8_BAR; }
    }
    PG8_WAIT_V(0);
    if constexpr (!ALIGN_EPI) { if (wr == 0) PG8_BAR; }
    PG8_BAR;
    if constexpr (Epi::AFTER_DRAIN) { E.fused(acc, cur, wr, wc, fr, fq, lds, wid, lane); S.done(cur); }
#undef PG8_SA
#undef PG8_SB
#undef PG8_STAGE
#undef PG8_LDA
#undef PG8_LDB
#undef PG8_MMA
#undef PG8_WAIT_V
#undef PG8_WAIT_L
#undef PG8_BAR
#undef PG8_SCHED
}
}

#define LAS __attribute__((address_space(3)))
typedef unsigned short bf16_t;
typedef short bf16x8 __attribute__((ext_vector_type(8)));
typedef float f32x4 __attribute__((ext_vector_type(4)));
typedef float f32x16 __attribute__((ext_vector_type(16)));
typedef unsigned u32x2 __attribute__((ext_vector_type(2)));
typedef unsigned u32x4 __attribute__((ext_vector_type(4)));

constexpr int DM = 1024, NB = 8, SEQ = 4096, TT = NB * SEQ, DEPTH = 4, NH = 8;
constexpr int QR = 384, KVR = 256, DFF = 2816, INW = 1952, INP = 2048;
constexpr float EPS = 1e-6f;
constexpr float QSCALE = 0.10206207261596575f * 1.4426950408889634f;
constexpr int NWAVES = 8, NTHR = 512;

constexpr size_t MiB = 1u << 20;
constexpr size_t WE_IN = 0, WE_UQ = WE_IN + (size_t)INP * DM, WE_UKV = WE_UQ + (size_t)768 * QR, WE_OUT = WE_UKV + (size_t)1024 * KVR,
                 WE_GU = WE_OUT + (size_t)DM * DM, WE_DN = WE_GU + (size_t)2 * DFF * DM, WE_WC = WE_DN + (size_t)DM * DFF, WE_LAYER = WE_WC + (size_t)4 * 128 * 128;
static_assert(WE_LAYER * 2 * DEPTH <= 96 * MiB, "weights region");
constexpr size_t WS_W = 0, WS_CS = 96 * MiB, WS_SS = 100 * MiB, WS_H = 112 * MiB, WS_R2 = 176 * MiB;
constexpr size_t WS_CTL = 110 * MiB, CTL_BYTES = 16384;
constexpr size_t WS_RS = 111 * MiB;
constexpr size_t SS_STRIDE = 2 * MiB;
constexpr size_t R_CQ = WS_R2, R_CKV = WS_R2 + 24 * MiB, R_U = WS_R2 + 40 * MiB, R_VNT = WS_R2 + 56 * MiB, R_Y = WS_R2 + 72 * MiB, R_GB = WS_R2 + 88 * MiB,
                 R_QF = WS_R2 + 104 * MiB, R_KF = WS_R2 + 152 * MiB, R_VT = WS_R2 + 200 * MiB, R_MIX = WS_R2 + 232 * MiB, WS_END = WS_R2 + 296 * MiB;
constexpr size_t R_F = R_QF, R_HMID = WS_R2, R_F2 = WS_R2 + 176 * MiB;

constexpr int LDS_BYTES = 132 * 1024;

struct Params {
    const float* x; const int* pos;
    const float *mix_pre_g, *mix_post_g, *ffn_pre_g, *ffn_post_g, *w_in, *q_norm_g, *w_uq, *kv_norm_g, *w_ukv, *sg_ln_g, *sg_ln_b, *w_sp, *b_sp, *conv_w,
                *out_norm_g, *w_out, *w_gate, *w_up, *w_down;
    float* out; unsigned char* ws;
    double inv_rev[16];
};

__device__ __forceinline__ unsigned pkbf(float lo, float hi) {
    typedef float f2_t __attribute__((ext_vector_type(2))); typedef __bf16 b2_t __attribute__((ext_vector_type(2)));
    f2_t v = {lo, hi}; b2_t b = __builtin_convertvector(v, b2_t); return __builtin_bit_cast(unsigned, b);
}
__device__ __forceinline__ bf16_t f2bf(float f) { return (bf16_t)(pkbf(f, 0.f) & 0xffffu); }
__device__ __forceinline__ float bflo(unsigned w) { return __uint_as_float(w << 16); }
__device__ __forceinline__ float bfhi(unsigned w) { return __uint_as_float(w & 0xffff0000u); }
__device__ __forceinline__ void store4(bf16_t* p, f32x4 v) { u32x2 w; w.x = pkbf(v[0], v[1]); w.y = pkbf(v[2], v[3]); *(u32x2*)p = w; }
__device__ __forceinline__ f32x4 load4bf(const bf16_t* p) { const u32x2 w = *(const u32x2*)p; return (f32x4){bflo(w.x), bfhi(w.x), bflo(w.y), bfhi(w.y)}; }
__device__ __forceinline__ float wave_sum(float v) {
#pragma unroll
    for (int o = 1; o < 64; o <<= 1) v += __shfl_xor(v, o);
    return v;
}
__device__ __forceinline__ float gelu_tanh(float x) {
    const float u = 0.7978845608028654f * (x + 0.044715f * x * x * x);
    return x * __builtin_amdgcn_rcpf(1.f + __builtin_amdgcn_exp2f(-2.f * 1.4426950408889634f * u));
}
__device__ __forceinline__ float silu_f(float x) { return x * __builtin_amdgcn_rcpf(1.f + __builtin_amdgcn_exp2f(-1.4426950408889634f * x)); }
__device__ __forceinline__ float dot4(f32x4 v) { return (v[0] * v[0] + v[1] * v[1]) + (v[2] * v[2] + v[3] * v[3]); }
__device__ __forceinline__ float sum4(f32x4 v) { return (v[0] + v[1]) + (v[2] + v[3]); }
__device__ __forceinline__ int crow(int r, int hi) { return (r & 3) + 8 * (r >> 2) + 4 * hi; }
__device__ __forceinline__ int opq(int v) { asm volatile("" : "+v"(v)); return v; }
#define TID_OPQ() opq((int)threadIdx.x)

typedef pg8::f32x4 pf4;
#define ACC_T const pf4 (&acc)[2][2][4][2]

struct EpiA {
    static constexpr bool PERM = false, AFTER_DRAIN = false;
    unsigned char* ws; const float *lng, *lnb;
    __device__ __forceinline__ void operator()(ACC_T, const pg8::Unit& u, int wr, int wc, int fr_, int fq_) const {
        const int fr = opq(fr_), fq = opq(fq_);
        bf16_t *CQ = (bf16_t*)(ws + R_CQ), *CKV = (bf16_t*)(ws + R_CKV), *U = (bf16_t*)(ws + R_U), *VNT = (bf16_t*)(ws + R_VNT), *Y = (bf16_t*)(ws + R_Y), *GB = (bf16_t*)(ws + R_GB), *Kf = (bf16_t*)(ws + R_KF);
        float *SSQ = (float*)(ws + WS_SS), *SSKV = (float*)(ws + WS_SS + SS_STRIDE); const float* CS = (const float*)(ws + WS_CS); const float* RS = (const float*)(ws + WS_RS);
        const int rbase = u.pm * 256 + wr * 64 + fr, cl = wc * 32 + 4 * fq;
        if (u.pn == 0 || u.pn == 2) {
            bf16_t* O = u.pn == 0 ? CQ : CKV; const int ld = u.pn == 0 ? QR : KVR; float* SS = u.pn == 0 ? SSQ : SSKV;
#pragma unroll
            for (int ai = 0; ai < 2; ++ai)
#pragma unroll
                for (int m = 0; m < 4; ++m) { const int row = rbase + 128 * ai + 16 * m; float s = 0.f; const float rx = RS[row];
#pragma unroll
                    for (int bj = 0; bj < 2; ++bj)
#pragma unroll
                        for (int n = 0; n < 2; ++n) { const f32x4 v = acc[ai][bj][m][n] * rx; s += dot4(v); store4(O + (size_t)row * ld + 128 * bj + cl + 16 * n, v); }
                    s += __shfl_xor(s, 16); s += __shfl_xor(s, 32);
                    if (fq == 0) SS[(size_t)row * 16 + wc] = s; asm volatile("" ::: "memory"); }
        } else if (u.pn == 1) {
#pragma unroll
            for (int ai = 0; ai < 2; ++ai)
#pragma unroll
                for (int m = 0; m < 4; ++m) { const int row = rbase + 128 * ai + 16 * m; float s = 0.f; const float rx = RS[row];
#pragma unroll
                    for (int n = 0; n < 2; ++n) { const f32x4 v = acc[ai][0][m][n] * rx; s += dot4(v); store4(CQ + (size_t)row * QR + 256 + cl + 16 * n, v); }
                    s += __shfl_xor(s, 16); s += __shfl_xor(s, 32);
                    if (fq == 0) SSQ[(size_t)row * 16 + 4 + wc] = s;
                    if (wc == 0) {
                        const f32x4 t1 = acc[ai][1][m][0] * rx, t2 = acc[ai][1][m][1] * rx;
                        const f32x4 c4 = *(const f32x4*)(CS + (size_t)row * 32 + 4 * fq), s4 = *(const f32x4*)(CS + (size_t)row * 32 + 16 + 4 * fq);
                        const f32x4 o1 = t1 * c4 - t2 * s4, o2 = t2 * c4 + t1 * s4;
                        const int b = row >> 12, sp = row & 4095;
#pragma unroll
                        for (int hd = 0; hd < NH; ++hd) { bf16_t* kp = Kf + ((size_t)(b * NH + hd) * SEQ + sp) * 96 + 64 + 4 * fq; store4(kp, o1); store4(kp + 16, o2); }
                    } asm volatile("" ::: "memory"); }
        } else if (u.pn == 3 || u.pn == 7) {
            bf16_t* O = u.pn == 3 ? U : GB; const bool act = (u.pn == 3);
#pragma unroll
            for (int ai = 0; ai < 2; ++ai)
#pragma unroll
                for (int m = 0; m < 4; ++m) { const int row = rbase + 128 * ai + 16 * m; const float rx = RS[row];
#pragma unroll
                    for (int bj = 0; bj < 2; ++bj)
#pragma unroll
                        for (int n = 0; n < 2; ++n) { f32x4 v = acc[ai][bj][m][n] * rx;
                            if (act) { v[0] = gelu_tanh(v[0]); v[1] = gelu_tanh(v[1]); v[2] = gelu_tanh(v[2]); v[3] = gelu_tanh(v[3]); }
                            store4(O + (size_t)row * 256 + 128 * bj + cl + 16 * n, v); } asm volatile("" ::: "memory"); }
        } else if (u.pn == 4) {
#pragma unroll
            for (int ai = 0; ai < 2; ++ai)
#pragma unroll
                for (int m = 0; m < 4; ++m) { const int row = rbase + 128 * ai + 16 * m; f32x4 g[2][2]; float s = 0.f; const float rx = RS[row];
#pragma unroll
                    for (int bj = 0; bj < 2; ++bj)
#pragma unroll
                        for (int n = 0; n < 2; ++n) { f32x4 v = acc[ai][bj][m][n] * rx; v[0] = gelu_tanh(v[0]); v[1] = gelu_tanh(v[1]); v[2] = gelu_tanh(v[2]); v[3] = gelu_tanh(v[3]); g[bj][n] = v; s += sum4(v); }
                    s += __shfl_xor(s, 16); s += __shfl_xor(s, 32);
                    const float mu = s * (1.f / 64.f); float q = 0.f;
#pragma unroll
                    for (int bj = 0; bj < 2; ++bj)
#pragma unroll
                        for (int n = 0; n < 2; ++n) { g[bj][n] = g[bj][n] - mu; q += dot4(g[bj][n]); }
                    q += __shfl_xor(q, 16); q += __shfl_xor(q, 32);
                    const float rstd = 1.f / sqrtf(q * (1.f / 64.f) + EPS);
                    bf16_t* vb = VNT + ((size_t)((row >> 7) * 4 + wc) * 64) * 128 + (row & 127);
#pragma unroll
                    for (int bj = 0; bj < 2; ++bj)
#pragma unroll
                        for (int n = 0; n < 2; ++n) { const int e = 32 * bj + 16 * n + 4 * fq; const f32x4 gg = *(const f32x4*)(lng + 64 * wc + e), bb = *(const f32x4*)(lnb + 64 * wc + e);
                            const f32x4 o = g[bj][n] * rstd * gg + bb;
#pragma unroll
                            for (int j = 0; j < 4; ++j) vb[(size_t)(e + j) * 128] = f2bf(o[j]); } asm volatile("" ::: "memory"); }
        } else {
            const int cb = 128 * (u.pn - 5) + cl;
#pragma unroll
            for (int ai = 0; ai < 2; ++ai)
#pragma unroll
                for (int m = 0; m < 4; ++m) { const int row = rbase + 128 * ai + 16 * m; const float rx = RS[row], rx2 = rx * rx;
#pragma unroll
                    for (int n = 0; n < 2; ++n) store4(Y + (size_t)row * 256 + cb + 16 * n, acc[ai][0][m][n] * acc[ai][1][m][n] * rx2); asm volatile("" ::: "memory"); }
        }
    }
};

struct EpiQ {
    static constexpr bool PERM = false, AFTER_DRAIN = false;
    bf16_t* Qf; const float* SSQ; const float* CS;
    __device__ __forceinline__ void operator()(ACC_T, const pg8::Unit& u, int wr, int wc, int fr_, int fq_) const {
        const int fr = opq(fr_), fq = opq(fq_);
        const int rbase = u.pm * 256 + wr * 64 + fr;
#pragma unroll
        for (int ai = 0; ai < 2; ++ai)
#pragma unroll
            for (int m = 0; m < 4; ++m) { const int row = rbase + 128 * ai + 16 * m;
                const f32x4 sa = *(const f32x4*)(SSQ + (size_t)row * 16), sb = *(const f32x4*)(SSQ + (size_t)row * 16 + 4);
                const float rs = QSCALE / sqrtf((sum4(sa) + sum4(sb)) * (1.f / QR) + EPS);
                const int b = row >> 12, sp = row & 4095;
#pragma unroll
                for (int bj = 0; bj < 2; ++bj) { const int p = 8 * u.pn + 4 * bj + wc, head = p / 3, part = p - 3 * head;
                    bf16_t* base = Qf + ((size_t)(b * NH + head) * SEQ + sp) * 96;
                    if (part < 2) {
#pragma unroll
                        for (int n = 0; n < 2; ++n) store4(base + 32 * part + 16 * n + 4 * fq, acc[ai][bj][m][n] * rs);
                    } else {
                        const f32x4 t1 = acc[ai][bj][m][0] * rs, t2 = acc[ai][bj][m][1] * rs;
                        const f32x4 c4 = *(const f32x4*)(CS + (size_t)row * 32 + 4 * fq), s4 = *(const f32x4*)(CS + (size_t)row * 32 + 16 + 4 * fq);
                        store4(base + 64 + 4 * fq, t1 * c4 - t2 * s4); store4(base + 80 + 4 * fq, t2 * c4 + t1 * s4);
                    } } asm volatile("" ::: "memory"); }
    }
};

struct EpiKV {
    static constexpr bool PERM = false, AFTER_DRAIN = false;
    bf16_t *Kf, *Vt; const float* SSKV;
    __device__ __forceinline__ void operator()(ACC_T, const pg8::Unit& u, int wr, int wc, int fr_, int fq_) const {
        const int fr = opq(fr_), fq = opq(fq_);
        const int rbase = u.pm * 256 + wr * 64 + fr;
#pragma unroll
        for (int ai = 0; ai < 2; ++ai)
#pragma unroll
            for (int m = 0; m < 4; ++m) { const int row = rbase + 128 * ai + 16 * m;
                const f32x4 sa = *(const f32x4*)(SSKV + (size_t)row * 16);
                const float rs = 1.f / sqrtf(sum4(sa) * (1.f / KVR) + EPS);
                const int b = row >> 12, sp = row & 4095;
#pragma unroll
                for (int bj = 0; bj < 2; ++bj) { const int p = 8 * u.pn + 4 * bj + wc, head = p >> 2, part = p & 3;
                    if (part < 2) { bf16_t* base = Kf + ((size_t)(b * NH + head) * SEQ + sp) * 96 + 32 * part + 4 * fq;
#pragma unroll
                        for (int n = 0; n < 2; ++n) store4(base + 16 * n, acc[ai][bj][m][n] * rs);
                    } else { bf16_t* base = Vt + ((size_t)(b * NH + head) * 64 + 32 * (part - 2) + 4 * fq) * SEQ + sp;
#pragma unroll
                        for (int n = 0; n < 2; ++n) { const f32x4 v = acc[ai][bj][m][n] * rs;
#pragma unroll
                            for (int j = 0; j < 4; ++j) base[(size_t)(16 * n + j) * SEQ] = f2bf(v[j]); } } } asm volatile("" ::: "memory"); }
    }
};

template <bool ROWSCALE> struct EpiF {
    static constexpr bool PERM = true, AFTER_DRAIN = false;
    bf16_t* F; float* SS; const float* SSA;
    __device__ __forceinline__ void operator()(ACC_T, const pg8::Unit& u, int wr, int wc, int fr_, int fq_) const {
        const int fr = opq(fr_), fq = opq(fq_);
        const int rbase = u.pm * 256 + wr * 64 + fr, cl = u.pn * 256 + wc * 32 + 8 * fq;
#pragma unroll
        for (int ai = 0; ai < 2; ++ai)
#pragma unroll
            for (int m = 0; m < 4; ++m) { const int row = rbase + 128 * ai + 16 * m; float s = 0.f; float ra = 1.f;
                if (ROWSCALE) { const float* sp = SSA + (size_t)row * 16; ra = __builtin_amdgcn_rsqf((sum4(*(const f32x4*)sp) + sum4(*(const f32x4*)(sp + 4))) * (1.f / 512.f) + EPS); }
#pragma unroll
                for (int bj = 0; bj < 2; ++bj) { const f32x4 v0 = acc[ai][bj][m][0] * ra, v1 = acc[ai][bj][m][1] * ra; s += dot4(v0) + dot4(v1);
                    u32x4 w; w.x = pkbf(v0[0], v0[1]); w.y = pkbf(v0[2], v0[3]); w.z = pkbf(v1[0], v1[1]); w.w = pkbf(v1[2], v1[3]);
                    *(u32x4*)(F + (size_t)row * DM + 128 * bj + cl) = w; }
                s += __shfl_xor(s, 16); s += __shfl_xor(s, 32);
                if (fq == 0) SS[(size_t)row * 16 + 4 * u.pn + wc] = s; asm volatile("" ::: "memory"); }
    }
};

struct EpiGU {
    static constexpr bool PERM = true, AFTER_DRAIN = false;
    bf16_t* HM; const float* RS;
    __device__ __forceinline__ void operator()(ACC_T, const pg8::Unit& u, int wr, int wc, int fr_, int fq_) const {
        const int fr = opq(fr_), fq = opq(fq_);
        const int rbase = u.pm * 256 + wr * 64 + fr, cb = u.pn * 128 + wc * 32 + 8 * fq;
#pragma unroll
        for (int ai = 0; ai < 2; ++ai)
#pragma unroll
            for (int m = 0; m < 4; ++m) { const int row = rbase + 128 * ai + 16 * m; const float rx = RS[row]; float o[8];
#pragma unroll
                for (int n = 0; n < 2; ++n) { const f32x4 g = acc[ai][0][m][n] * rx, up = acc[ai][1][m][n] * rx;
#pragma unroll
                    for (int j = 0; j < 4; ++j) o[4 * n + j] = silu_f(g[j]) * up[j]; }
                u32x4 w; w.x = pkbf(o[0], o[1]); w.y = pkbf(o[2], o[3]); w.z = pkbf(o[4], o[5]); w.w = pkbf(o[6], o[7]);
                *(u32x4*)(HM + (size_t)row * DFF + cb) = w; asm volatile("" ::: "memory"); }
    }
};

__device__ __forceinline__ void conv_item(const float* src, int ldsrc, const float* gain, int k0, bf16_t* dst, int K, LAS float* scr, int lane) {
    float v[32];
    if (src) { const float* sp = src + (size_t)(k0 + (lane >> 5)) * ldsrc + (lane & 31);
#pragma unroll
        for (int i = 0; i < 32; ++i) v[i] = sp[(size_t)(2 * i) * ldsrc];
    } else {
#pragma unroll
        for (int i = 0; i < 32; ++i) v[i] = 0.f;
    }
#pragma unroll
    for (int i = 0; i < 32; ++i) scr[(2 * i + (lane >> 5)) * 33 + (lane & 31)] = v[i];
    asm volatile("s_waitcnt lgkmcnt(0)" ::: "memory");
    const int c = lane & 7;
    f32x4 g0 = (f32x4){1.f, 1.f, 1.f, 1.f}, g1 = g0;
    if (gain) { g0 = *(const f32x4*)(gain + k0 + 8 * c); g1 = *(const f32x4*)(gain + k0 + 8 * c + 4); }
#pragma unroll
    for (int j = 0; j < 4; ++j) { const int n = (lane >> 3) + 8 * j; const LAS float* t = scr + (8 * c) * 33 + n;
        u32x4 o; o.x = pkbf(t[0 * 33] * g0[0], t[1 * 33] * g0[1]); o.y = pkbf(t[2 * 33] * g0[2], t[3 * 33] * g0[3]); o.z = pkbf(t[4 * 33] * g1[0], t[5 * 33] * g1[1]); o.w = pkbf(t[6 * 33] * g1[2], t[7 * 33] * g1[3]);
        *(u32x4*)(dst + (size_t)n * K + k0 + 8 * c) = o; }
    asm volatile("s_waitcnt lgkmcnt(0)" ::: "memory");
}
__device__ __forceinline__ int zcol_of_block(int nb) {
    const int tile = nb >> 3, q = nb & 7;
    switch (tile) {
        case 0: return 32 * nb;
        case 1: return q < 4 ? 256 + 32 * q : (q == 4 ? 640 : -1);
        case 2: return 384 + 32 * q;
        case 3: return 672 + 32 * q;
        case 4: return 928 + 64 * (q & 3) + 32 * (q >> 2);
        case 5: return q < 4 ? 1440 + 32 * q : 1696 + 32 * (q - 4);
        case 6: return q < 4 ? 1568 + 32 * q : 1824 + 32 * (q - 4);
        default: return 1184 + 32 * q;
    }
}
constexpr int IT_IN = 64 * 16, IT_UQ = 24 * 6, IT_UKV = 32 * 4, IT_OUT = 32 * 16, IT_GU = 176 * 16, IT_DN = 32 * 44, IT_LAYER = IT_IN + IT_UQ + IT_UKV + IT_OUT + IT_GU + IT_DN;

__device__ __forceinline__ void p0_prologue(const Params& P, LAS unsigned char* lds) {
    const int tid = TID_OPQ(), lane = tid & 63, wid = tid >> 6;
    const int gw = blockIdx.x * NWAVES + wid, NGW = gridDim.x * NWAVES;
    LAS float* scr = (LAS float*)(lds + wid * 16384);
    bf16_t* W = (bf16_t*)(P.ws + WS_W);
    for (int it = gw; it < IT_LAYER * DEPTH; it += NGW) {
        const int l = it / IT_LAYER; int r = it - l * IT_LAYER; bf16_t* Wl = W + (size_t)l * WE_LAYER;
        if (r < IT_IN) { const int nb = r >> 4, kb = r & 15, zc = zcol_of_block(nb);
            conv_item(zc >= 0 ? P.w_in + (size_t)l * DM * INW + zc : nullptr, INW, P.mix_pre_g + l * DM, 64 * kb, Wl + WE_IN + (size_t)(32 * nb) * DM, DM, scr, lane); continue; } r -= IT_IN;
        if (r < IT_UQ) { const int nb = r / 6, kb = r - 6 * nb;
            conv_item(P.w_uq + (size_t)l * QR * 768 + 32 * nb, 768, P.q_norm_g + l * QR, 64 * kb, Wl + WE_UQ + (size_t)(32 * nb) * QR, QR, scr, lane); continue; } r -= IT_UQ;
        if (r < IT_UKV) { const int nb = r >> 2, kb = r & 3;
            conv_item(P.w_ukv + (size_t)l * KVR * 1024 + 32 * nb, 1024, P.kv_norm_g + l * KVR, 64 * kb, Wl + WE_UKV + (size_t)(32 * nb) * KVR, KVR, scr, lane); continue; } r -= IT_UKV;
        if (r < IT_OUT) { const int nb = r >> 4, kb = r & 15;
            conv_item(P.w_out + (size_t)l * DM * DM + 32 * nb, DM, P.out_norm_g + l * DM, 64 * kb, Wl + WE_OUT + (size_t)(32 * nb) * DM, DM, scr, lane); continue; } r -= IT_OUT;
        if (r < IT_GU) { const int nb = r >> 4, kb = r & 15, tile = nb >> 3, q = nb & 7;
            const float* src = (q < 4 ? P.w_gate : P.w_up) + (size_t)l * DM * DFF + 128 * tile + 32 * (q & 3);
            conv_item(src, DFF, P.ffn_pre_g + l * DM, 64 * kb, Wl + WE_GU + (size_t)(32 * nb) * DM, DM, scr, lane); continue; } r -= IT_GU;
        { const int nb = r / 44, kb = r - 44 * nb;
            conv_item(P.w_down + (size_t)l * DFF * DM + 32 * nb, DM, nullptr, 64 * kb, Wl + WE_DN + (size_t)(32 * nb) * DFF, DFF, scr, lane); }
    }
    const int gt = blockIdx.x * NTHR + tid, NGT = gridDim.x * NTHR;
    for (int i = gt; i < DEPTH * 4 * 128 * 128; i += NGT) { const int l = i >> 16, rem = i & 65535, t = (rem >> 7) & 127, s = rem & 127;
        W[(size_t)l * WE_LAYER + WE_WC + rem] = (s <= t) ? f2bf(P.w_sp[i]) : (bf16_t)0; }
    float* CS = (float*)(P.ws + WS_CS);
    for (int i = gt; i < TT * 16; i += NGT) { const int row = i >> 4, k = i & 15; const double rev = (double)P.pos[row] * P.inv_rev[k]; const float fr = (float)(rev - rint(rev));
        CS[(size_t)row * 32 + k] = __builtin_amdgcn_cosf(fr); CS[(size_t)row * 32 + 16 + k] = __builtin_amdgcn_sinf(fr); }
    bf16_t* H = (bf16_t*)(P.ws + WS_H); float* RSp = (float*)(P.ws + WS_RS);
    for (int row = 2 * gw; row < TT; row += 2 * NGW) { f32x4 v[2][4]; float ssq[2];
#pragma unroll
        for (int i = 0; i < 2; ++i) { const float* xr = P.x + (size_t)(row + i) * DM + 4 * lane;
#pragma unroll
            for (int j = 0; j < 4; ++j) v[i][j] = *(const f32x4*)(xr + 256 * j); }
#pragma unroll
        for (int i = 0; i < 2; ++i) ssq[i] = (dot4(v[i][0]) + dot4(v[i][1])) + (dot4(v[i][2]) + dot4(v[i][3]));
#pragma unroll
        for (int o = 1; o < 64; o <<= 1) { ssq[0] += __shfl_xor(ssq[0], o); ssq[1] += __shfl_xor(ssq[1], o); }
#pragma unroll
        for (int i = 0; i < 2; ++i) { if (lane == 0) RSp[row + i] = 1.f / sqrtf(ssq[i] * (1.f / DM) + EPS);
#pragma unroll
            for (int j = 0; j < 4; ++j) store4(H + (size_t)(row + i) * DM + 4 * lane + 256 * j, v[i][j]); } }
}

__device__ __forceinline__ void resid_phase(bf16_t* XB, const bf16_t* F, const float* SS, const float* gpost, float* RS, float* outf) {
    const int tid = TID_OPQ(), lane = tid & 63, wid = tid >> 6;
    const int gw = blockIdx.x * NWAVES + wid, NGW = gridDim.x * NWAVES;
    f32x4 g4[4];
#pragma unroll
    for (int j = 0; j < 4; ++j) g4[j] = *(const f32x4*)(gpost + 4 * lane + 256 * j);
    for (int row = 2 * gw; row < TT; row += 2 * NGW) {
        f32x4 v[2][4], f[2][4]; float rs[2], s2[2];
#pragma unroll
        for (int i = 0; i < 2; ++i) { const float* sp = SS + (size_t)(row + i) * 16;
            rs[i] = (sum4(*(const f32x4*)sp) + sum4(*(const f32x4*)(sp + 4))) + (sum4(*(const f32x4*)(sp + 8)) + sum4(*(const f32x4*)(sp + 12)));
#pragma unroll
            for (int j = 0; j < 4; ++j) { const size_t o = (size_t)(row + i) * DM + 4 * lane + 256 * j; v[i][j] = load4bf(XB + o); f[i][j] = load4bf(F + o); } }
#pragma unroll
        for (int i = 0; i < 2; ++i) { const float r = 1.f / sqrtf(rs[i] * (1.f / DM) + EPS); s2[i] = 0.f;
#pragma unroll
            for (int j = 0; j < 4; ++j) { v[i][j] = v[i][j] + f[i][j] * r * g4[j]; s2[i] += dot4(v[i][j]); } }
        if (outf) {
#pragma unroll
            for (int i = 0; i < 2; ++i)
#pragma unroll
                for (int j = 0; j < 4; ++j) *(f32x4*)(outf + (size_t)(row + i) * DM + 4 * lane + 256 * j) = v[i][j];
        } else {
#pragma unroll
            for (int i = 0; i < 2; ++i)
#pragma unroll
                for (int j = 0; j < 4; ++j) store4(XB + (size_t)(row + i) * DM + 4 * lane + 256 * j, v[i][j]);
#pragma unroll
            for (int o = 1; o < 64; o <<= 1) { s2[0] += __shfl_xor(s2[0], o); s2[1] += __shfl_xor(s2[1], o); }
            if (lane < 2) RS[row + lane] = 1.f / sqrtf((lane == 0 ? s2[0] : s2[1]) * (1.f / DM) + EPS);
        }
    }
}

constexpr int KSTR = 208, VSTR = 136, KBUF = 64 * KSTR, VBUF = 64 * VSTR;
constexpr int LDS_K0 = 0, LDS_V0 = 2 * KBUF;
#define MFMA32(a, b, c) __builtin_amdgcn_mfma_f32_32x32x16_bf16((a), (b), (c), 0, 0, 0)

__device__ __forceinline__ void att_qk(f32x16& p0, f32x16& p1, const LAS unsigned char* kb, const bf16x8 (&qf)[6]) {
#pragma unroll
    for (int r = 0; r < 16; ++r) { p0[r] = 0.f; p1[r] = 0.f; }
#pragma unroll
    for (int ks = 0; ks < 6; ++ks) { const bf16x8 a0 = *(const LAS bf16x8*)(kb + 32 * ks), a1 = *(const LAS bf16x8*)(kb + 32 * KSTR + 32 * ks);
        p0 = MFMA32(a0, qf[ks], p0); p1 = MFMA32(a1, qf[ks], p1); }
}
__device__ __forceinline__ void att_sm_pv(f32x16& p0, f32x16& p1, f32x16& o0, f32x16& o1, float& mrun, float& lrun, int jb, int qrel, int hi, const LAS unsigned char* vb) {
    if (jb >= 0) {
#pragma unroll
        for (int r = 0; r < 16; ++r) { const int kv = 64 * jb + crow(r, hi); if (kv > qrel) p0[r] = -1e30f; if (kv + 32 > qrel) p1[r] = -1e30f; }
    }
    float mx = fmaxf(p0[0], p1[0]);
#pragma unroll
    for (int r = 1; r < 16; ++r) mx = fmaxf(mx, fmaxf(p0[r], p1[r]));
    mx = fmaxf(mx, __shfl_xor(mx, 32));
    if (__any(mx > mrun)) {
        const float mnew = fmaxf(mrun, mx), alpha = __builtin_amdgcn_exp2f(mrun - mnew); mrun = mnew; lrun *= alpha;
#pragma unroll
        for (int r = 0; r < 16; ++r) { o0[r] *= alpha; o1[r] *= alpha; }
    }
    float ls = 0.f;
#pragma unroll
    for (int r = 0; r < 16; ++r) { p0[r] = __builtin_amdgcn_exp2f(p0[r] - mrun); p1[r] = __builtin_amdgcn_exp2f(p1[r] - mrun); ls += p0[r] + p1[r]; }
    lrun += ls;
    bf16x8 pf[4];
#pragma unroll
    for (int s = 0; s < 2; ++s) { u32x4 w0, w1;
        w0.x = pkbf(p0[8 * s], p0[8 * s + 1]); w0.y = pkbf(p0[8 * s + 2], p0[8 * s + 3]); w0.z = pkbf(p0[8 * s + 4], p0[8 * s + 5]); w0.w = pkbf(p0[8 * s + 6], p0[8 * s + 7]);
        w1.x = pkbf(p1[8 * s], p1[8 * s + 1]); w1.y = pkbf(p1[8 * s + 2], p1[8 * s + 3]); w1.z = pkbf(p1[8 * s + 4], p1[8 * s + 5]); w1.w = pkbf(p1[8 * s + 6], p1[8 * s + 7]);
        pf[s] = __builtin_bit_cast(bf16x8, w0); pf[2 + s] = __builtin_bit_cast(bf16x8, w1); }
#pragma unroll
    for (int pb = 0; pb < 2; ++pb)
#pragma unroll
        for (int s = 0; s < 2; ++s) { const int off = (32 * pb + 16 * s) * 2;
            const u32x2 a_lo = *(const LAS u32x2*)(vb + off), a_hi = *(const LAS u32x2*)(vb + off + 16);
            const u32x2 b_lo = *(const LAS u32x2*)(vb + 32 * VSTR + off), b_hi = *(const LAS u32x2*)(vb + 32 * VSTR + off + 16);
            const bf16x8 va = __builtin_bit_cast(bf16x8, (u32x4){a_lo.x, a_lo.y, a_hi.x, a_hi.y}), vbb = __builtin_bit_cast(bf16x8, (u32x4){b_lo.x, b_lo.y, b_hi.x, b_hi.y});
            o0 = MFMA32(va, pf[2 * pb + s], o0); o1 = MFMA32(vbb, pf[2 * pb + s], o1); }
}

__device__ __forceinline__ void attn_unit(LAS unsigned char* lds, int bh, int qb, const bf16_t* Qf, const bf16_t* Kf, const bf16_t* Vt, bf16_t* MIX, float* SSA) {
    const int tid = TID_OPQ(), lane = tid & 63, wid = __builtin_amdgcn_readfirstlane(tid >> 6), r32 = lane & 31, hi = lane >> 5;
    const bool grpB = wid >= 4;
    const bf16_t* Kh = Kf + (size_t)bh * SEQ * 96; const bf16_t* Vh = Vt + (size_t)bh * 64 * SEQ; const bf16_t* Qh = Qf + (size_t)bh * SEQ * 96;
    const int q0 = qb * 256, NT = 4 * qb + 4;
    bf16x8 qf[6];
    { const bf16_t* qp = Qh + (size_t)(q0 + 32 * wid + r32) * 96 + 8 * hi;
#pragma unroll
      for (int ks = 0; ks < 6; ++ks) qf[ks] = *(const bf16x8*)(qp + 16 * ks); }
    const int kr0 = tid / 12, kc0 = tid - 12 * kr0, i1 = 512 + tid, kr1 = i1 / 12, kc1 = i1 - 12 * kr1;
    const int kl0 = kr0 * KSTR + kc0 * 16, kl1 = kr1 * KSTR + kc1 * 16;
    const int vl = (tid >> 3) * VSTR + (tid & 7) * 16;
    const bf16_t* kg = Kh + (size_t)tid * 8; const bf16_t* vg = Vh + (size_t)(tid >> 3) * SEQ + (tid & 7) * 8;
    u32x4 kreg0, kreg1 = (u32x4){0u, 0u, 0u, 0u}, vreg;
#define ATT_LOAD(t) do { kreg0 = *(const u32x4*)(kg + (size_t)(t) * 64 * 96); if (tid < 256) kreg1 = *(const u32x4*)(kg + (size_t)(t) * 64 * 96 + 512 * 8); vreg = *(const u32x4*)(vg + (t) * 64); } while (0)
#define ATT_STORE(kbuf, vbuf) do { *(LAS u32x4*)(lds + LDS_K0 + (kbuf) * KBUF + kl0) = kreg0; if (tid < 256) *(LAS u32x4*)(lds + LDS_K0 + (kbuf) * KBUF + kl1) = kreg1; \
        *(LAS u32x2*)(lds + LDS_V0 + (vbuf) * VBUF + vl) = (u32x2){vreg.x, vreg.y}; *(LAS u32x2*)(lds + LDS_V0 + (vbuf) * VBUF + vl + 8) = (u32x2){vreg.z, vreg.w}; } while (0)
    f32x16 o0, o1, p0, p1;
#pragma unroll
    for (int r = 0; r < 16; ++r) { o0[r] = 0.f; o1[r] = 0.f; p0[r] = 0.f; p1[r] = 0.f; }
    float mrun = -1e30f, lrun = 0.f;
    const int qrel = 32 * wid + r32, wlim = wid >> 1;
    const LAS unsigned char* kbase = lds + LDS_K0 + r32 * KSTR + 16 * hi;
    const LAS unsigned char* vbase = lds + LDS_V0 + r32 * VSTR + 8 * hi;
    ATT_LOAD(0); ATT_STORE(0, 0); __syncthreads();
    bool have_prev = false; int vcur = 0, vprev = 0;
    for (int t = 0; t <= NT; ++t) {
        const int vnext = (vcur == 2) ? 0 : vcur + 1;
        if (t + 1 < NT) ATT_LOAD(t + 1);
        const int jb = t - (NT - 4);
        const bool need = (t < NT) && (jb <= wlim);
        if (!grpB) {
            if (need) { att_qk(p0, p1, kbase + (t & 1) * KBUF, qf); att_sm_pv(p0, p1, o0, o1, mrun, lrun, jb, qrel, hi, vbase + vcur * VBUF); }
        } else {
            if (have_prev) att_sm_pv(p0, p1, o0, o1, mrun, lrun, jb - 1, qrel, hi, vbase + vprev * VBUF);
            have_prev = need;
            if (need) att_qk(p0, p1, kbase + (t & 1) * KBUF, qf);
        }
        if (t + 1 < NT) ATT_STORE((t + 1) & 1, vnext);
        vprev = vcur; vcur = vnext;
        __syncthreads();
    }
#undef ATT_LOAD
#undef ATT_STORE
    const float ltot = lrun + __shfl_xor(lrun, 32), inv = 1.f / ltot;
    float ss = 0.f;
#pragma unroll
    for (int r = 0; r < 16; ++r) { o0[r] *= inv; o1[r] *= inv; ss += o0[r] * o0[r] + o1[r] * o1[r]; }
    ss += __shfl_xor(ss, 32);
    const int b = bh >> 3, h = bh & 7; const size_t row = (size_t)b * SEQ + q0 + 32 * wid + r32;
    if (hi == 0) SSA[row * 16 + h] = ss;
    bf16_t* op = MIX + row * DM + h * 64 + 4 * hi;
#pragma unroll
    for (int g4 = 0; g4 < 4; ++g4) { store4(op + 8 * g4, (f32x4){o0[4 * g4], o0[4 * g4 + 1], o0[4 * g4 + 2], o0[4 * g4 + 3]});
        store4(op + 32 + 8 * g4, (f32x4){o1[4 * g4], o1[4 * g4 + 1], o1[4 * g4 + 2], o1[4 * g4 + 3]}); }
}
__device__ __forceinline__ void attn_phase(LAS unsigned char* lds, const bf16_t* Qf, const bf16_t* Kf, const bf16_t* Vt, bf16_t* MIX, float* SSA) {
    const int G = gridDim.x, bx = blockIdx.x; const int vcu = (G % 8 == 0) ? (bx % 8) * (G / 8) + bx / 8 : bx;
    for (int w = vcu; w < 256; w += G) { const int bh = w >> 2, s4 = w & 3;
#pragma unroll 1
        for (int i = 0; i < 4; ++i) { const int qb = (i == 0) ? 15 - s4 : (i == 1) ? 8 + s4 : (i == 2) ? 7 - s4 : s4; attn_unit(lds, bh, qb, Qf, Kf, Vt, MIX, SSA); } }
}

__device__ __forceinline__ void sgu_unit(LAS unsigned char* lds, int chunk, const bf16_t* VNT, const bf16_t* WC, const float* bsp, const bf16_t* U, const float* SSA, bf16_t* MIX) {
    const int tid = TID_OPQ(), lane = tid & 63, wid = __builtin_amdgcn_readfirstlane(tid >> 6), r32 = lane & 31, hi = lane >> 5;
    const int g = wid >> 1, th = wid & 1;
    LAS float* red = (LAS float*)lds;
    const bf16_t* ap = VNT + ((size_t)(chunk * 4 + g) * 64 + r32) * 128 + 8 * hi;
    const bf16_t* bp = WC + ((size_t)g * 128 + 64 * th + r32) * 128 + 8 * hi;
    f32x16 acc[2][2];
#pragma unroll
    for (int a = 0; a < 2; ++a)
#pragma unroll
        for (int b = 0; b < 2; ++b)
#pragma unroll
            for (int r = 0; r < 16; ++r) acc[a][b][r] = 0.f;
#pragma unroll
    for (int ks = 0; ks < 8; ++ks) {
        const bf16x8 a0 = *(const bf16x8*)(ap + 16 * ks), a1 = *(const bf16x8*)(ap + 32 * 128 + 16 * ks);
        const bf16x8 b0 = *(const bf16x8*)(bp + 16 * ks), b1 = *(const bf16x8*)(bp + 32 * 128 + 16 * ks);
        acc[0][0] = MFMA32(a0, b0, acc[0][0]); acc[0][1] = MFMA32(a0, b1, acc[0][1]); acc[1][0] = MFMA32(a1, b0, acc[1][0]); acc[1][1] = MFMA32(a1, b1, acc[1][1]);
    }
#pragma unroll
    for (int tb = 0; tb < 2; ++tb) { const int t = 64 * th + 32 * tb + r32; const size_t row = (size_t)chunk * 128 + t; const float bias = bsp[g * 128 + t]; float ss = 0.f;
#pragma unroll
        for (int eb = 0; eb < 2; ++eb)
#pragma unroll
            for (int g4 = 0; g4 < 4; ++g4) { const f32x4 uu = load4bf(U + row * 256 + g * 64 + 32 * eb + 8 * g4 + 4 * hi);
#pragma unroll
                for (int j = 0; j < 4; ++j) { const float v = uu[j] * (acc[eb][tb][4 * g4 + j] + bias); acc[eb][tb][4 * g4 + j] = v; ss += v * v; } }
        ss += __shfl_xor(ss, 32);
        if (hi == 0) red[g * 128 + t] = ss; }
    __syncthreads();
#pragma unroll
    for (int tb = 0; tb < 2; ++tb) { const int t = 64 * th + 32 * tb + r32; const size_t row = (size_t)chunk * 128 + t;
        const float* sa = SSA + row * 16; const float rai = sqrtf((sum4(*(const f32x4*)sa) + sum4(*(const f32x4*)(sa + 4))) * (1.f / 512.f) + EPS);
        const float tot = (red[t] + red[128 + t]) + (red[256 + t] + red[384 + t]); const float rs = rai / sqrtf(tot * (1.f / 256.f) + EPS);
#pragma unroll
        for (int eb = 0; eb < 2; ++eb)
#pragma unroll
            for (int g4 = 0; g4 < 4; ++g4) store4(MIX + row * DM + 512 + g * 64 + 32 * eb + 8 * g4 + 4 * hi,
                (f32x4){acc[eb][tb][4 * g4] * rs, acc[eb][tb][4 * g4 + 1] * rs, acc[eb][tb][4 * g4 + 2] * rs, acc[eb][tb][4 * g4 + 3] * rs}); }
    __syncthreads();
}
__device__ __forceinline__ void light_phase(LAS unsigned char* lds, const bf16_t* VNT, const bf16_t* WC, const float* bsp, const bf16_t* U, const bf16_t* Y, const bf16_t* GB,
                                            const float* cw, const float* SSA, bf16_t* MIX) {
    for (int c = blockIdx.x; c < TT / 128; c += gridDim.x) sgu_unit(lds, c, VNT, WC, bsp, U, SSA, MIX);
    const int tid = TID_OPQ(), lane = tid & 63, wid = tid >> 6;
    const int gw = blockIdx.x * NWAVES + wid, NGW = gridDim.x * NWAVES;
    const f32x4 w0 = *(const f32x4*)(cw + 4 * lane), w1 = *(const f32x4*)(cw + 256 + 4 * lane), w2 = *(const f32x4*)(cw + 512 + 4 * lane);
    for (int r0 = 8 * gw; r0 < TT; r0 += 8 * NGW) { const bool first = (r0 & 4095) == 0; f32x4 y[10], gb[8], yc[8]; float ss[8];
        y[0] = first ? (f32x4){0.f, 0.f, 0.f, 0.f} : load4bf(Y + (size_t)(r0 - 2) * 256 + 4 * lane);
        y[1] = first ? (f32x4){0.f, 0.f, 0.f, 0.f} : load4bf(Y + (size_t)(r0 - 1) * 256 + 4 * lane);
#pragma unroll
        for (int i = 0; i < 8; ++i) { y[i + 2] = load4bf(Y + (size_t)(r0 + i) * 256 + 4 * lane); gb[i] = load4bf(GB + (size_t)(r0 + i) * 256 + 4 * lane); }
#pragma unroll
        for (int i = 0; i < 8; ++i) { yc[i] = gb[i] * (y[i] * w0 + y[i + 1] * w1 + y[i + 2] * w2); ss[i] = dot4(yc[i]); }
#pragma unroll
        for (int o = 1; o < 64; o <<= 1) {
#pragma unroll
            for (int i = 0; i < 8; ++i) ss[i] += __shfl_xor(ss[i], o); }
#pragma unroll
        for (int i = 0; i < 8; ++i) { const float* sa = SSA + (size_t)(r0 + i) * 16; const float rai = sqrtf((sum4(*(const f32x4*)sa) + sum4(*(const f32x4*)(sa + 4))) * (1.f / 512.f) + EPS);
            store4(MIX + (size_t)(r0 + i) * DM + 768 + 4 * lane, yc[i] * (rai / sqrtf(ss[i] * (1.f / 256.f) + EPS))); } }
}

#define XB_TMO      128
#define XB_XCNT(j)  (256  + 64 * (j))
#define XB_XSUB(j)  (1280 + 64 * (j))
#define XB_XGEN(j)  (2304 + 64 * (j))
#define XB_TOP      3328
#define XB_TOPGEN   3392
#define XCD_BAR_WORDS 3456
#define XB_SPIN_CAP (1u << 18)

__device__ __forceinline__ unsigned xb_ld(unsigned* p)              { return __hip_atomic_load(p, __ATOMIC_RELAXED, __HIP_MEMORY_SCOPE_AGENT); }
__device__ __forceinline__ unsigned xb_add(unsigned* p, unsigned v) { return __hip_atomic_fetch_add(p, v, __ATOMIC_RELAXED, __HIP_MEMORY_SCOPE_AGENT); }
__device__ __forceinline__ unsigned xb_xcc_id() { return (unsigned)__builtin_amdgcn_s_getreg((3 << 11) | 20) & 0xFu; }
#define XB_SPIN(cond, bar) do { unsigned _sp = 0; while (cond) { __builtin_amdgcn_s_sleep(1); \
    if ((++_sp & 255u) == 0u) { if (xb_ld(&(bar)[XB_TMO])) break; if (_sp > XB_SPIN_CAP) { atomicAdd(&(bar)[XB_TMO], 1u); break; } } } } while (0)

struct XcdBarrier {
    unsigned* bar; unsigned x;
    volatile LAS unsigned* st;
};

__device__ __forceinline__ XcdBarrier xcd_barrier_post(unsigned* bar, volatile LAS unsigned* st) {
    XcdBarrier b; b.bar = bar; b.x = xb_xcc_id(); b.st = st;
    if (threadIdx.x == 0) (void)xb_add(&bar[XB_XCNT(b.x)], 1u);
    return b;
}
__device__ __forceinline__ void xcd_barrier_complete(unsigned* bar, unsigned x, unsigned& nloc, unsigned& nx) {
    const unsigned G = gridDim.x * gridDim.y * gridDim.z;
    unsigned sum, cnt, mine, sp = 0u;
    for (;;) {
        sum = 0u; cnt = 0u; mine = 0u;
#pragma unroll
        for (unsigned j = 0; j < 16; ++j) { const unsigned c = xb_ld(&bar[XB_XCNT(j)]); sum += c; cnt += (c > 0u) ? 1u : 0u; mine = (j == x) ? c : mine; }
        if (sum == G) break;
        __builtin_amdgcn_s_sleep(1);
        if ((++sp & 255u) == 0u) { if (xb_ld(&bar[XB_TMO])) break; if (sp > XB_SPIN_CAP) { atomicAdd(&bar[XB_TMO], 1u); break; } }
    }
    nloc = mine > 0u ? mine : 1u; nx = cnt > 0u ? cnt : 1u;
}

__device__ __forceinline__ void xcd_barrier(const XcdBarrier& b) {
    asm volatile("s_waitcnt vmcnt(0)" ::: "memory");
    __syncthreads();
    if (threadIdx.x == 0) {
        unsigned* bar = b.bar;
        __builtin_amdgcn_s_waitcnt(0);
        unsigned nloc = b.st[0], nx = b.st[1];
        if (nloc == 0u) { xcd_barrier_complete(bar, b.x, nloc, nx); b.st[0] = nloc; b.st[1] = nx; }
        const unsigned old = xb_add(&bar[XB_XSUB(b.x)], 1u);
        const unsigned gen = old / nloc;
        if (old + 1u == (gen + 1u) * nloc) {
            __builtin_amdgcn_fence(__ATOMIC_RELEASE, "agent");
            asm volatile("s_waitcnt vmcnt(0)" ::: "memory");
            const unsigned og = xb_add(&bar[XB_TOP], 1u);
            const unsigned tg = og / nx;
            if (og + 1u == (tg + 1u) * nx) xb_add(&bar[XB_TOPGEN], 1u);
            else XB_SPIN(xb_ld(&bar[XB_TOPGEN]) == tg, bar);
            __builtin_amdgcn_fence(__ATOMIC_ACQUIRE, "agent");
            xb_add(&bar[XB_XGEN(b.x)], 1u);
            asm volatile("s_waitcnt vmcnt(0)" ::: "memory");
        } else {
            XB_SPIN(xb_ld(&bar[XB_XGEN(b.x)]) == gen, bar);
            __builtin_amdgcn_fence(__ATOMIC_ACQUIRE, "agent");
            asm volatile("s_waitcnt vmcnt(0)" ::: "memory");
        }
    }
    __syncthreads();
}

#ifndef REP_SYNC
#define REP_SYNC 1
#endif
#define GSYNC() do { for (int rs_ = 0; rs_ < REP_SYNC; ++rs_) xcd_barrier(xbar); } while (0)
#ifndef REP_P0
#define REP_P0 1
#endif
#ifndef REP_R0
#define REP_R0 1
#endif
#ifndef REP_G1
#define REP_G1 1
#endif
#ifndef REP_G2
#define REP_G2 1
#endif
#ifndef REP_LIGHT
#define REP_LIGHT 1
#endif
#ifndef REP_ATT
#define REP_ATT 1
#endif
#ifndef REP_GEMM
#define REP_GEMM 1
#endif
#define GEMM_PHASE(EPI, Aptr, Bptr, Mv, Nv, Kv, Eobj) for (int rep_ = 0; rep_ < REP_GEMM; ++rep_) do { int k_ = (Kv); asm volatile("" : "+s"(k_)); pg8::Gemm g_{(const pg8::bf16_t*)(Aptr), (const pg8::bf16_t*)(Bptr), (Mv), (Nv), k_}; pg8::StaticOrder S_; S_.init((Mv), (Nv), (int)gridDim.x, (int)blockIdx.x); \
        pg8::gemm_phase<EPI, pg8::StaticOrder, true, true>(lds, g_, S_, (Eobj)); } while (0)


__device__ __forceinline__ unsigned char* opq_ws(unsigned char* p) { asm volatile("" : "+s"(p)); return p; }
#define WSP(T, off) ((T*)(opq_ws(P.ws) + (off)))
#define W_ WSP(bf16_t, WS_W)
#define CS_ WSP(float, WS_CS)
#define SSQ_ WSP(float, WS_SS)
#define SSKV_ WSP(float, WS_SS + SS_STRIDE)
#define SSA_ WSP(float, WS_SS + 2 * SS_STRIDE)
#define SSF_ WSP(float, WS_SS + 3 * SS_STRIDE)
#define SSF2_ WSP(float, WS_SS + 4 * SS_STRIDE)
#define H_ WSP(bf16_t, WS_H)
#define CQ_ WSP(bf16_t, R_CQ)
#define CKV_ WSP(bf16_t, R_CKV)
#define U_ WSP(bf16_t, R_U)
#define VNT_ WSP(bf16_t, R_VNT)
#define Y_ WSP(bf16_t, R_Y)
#define GB_ WSP(bf16_t, R_GB)
#define QF_ WSP(bf16_t, R_QF)
#define KF_ WSP(bf16_t, R_KF)
#define VT_ WSP(bf16_t, R_VT)
#define MIX_ WSP(bf16_t, R_MIX)
#define F_ WSP(bf16_t, R_F)
#define HMID_ WSP(bf16_t, R_HMID)
#define F2_ WSP(bf16_t, R_F2)
__global__ void __launch_bounds__(NTHR, 2) fwd_kernel(Params P) {
    extern __shared__ __attribute__((aligned(16))) unsigned char lds_raw[];
    LAS unsigned char* lds = (LAS unsigned char*)lds_raw;
    cg::grid_group grid = cg::this_grid();
    volatile LAS unsigned* xst = (volatile LAS unsigned*)(lds + 131072 + 128);
    if (threadIdx.x < 2) xst[threadIdx.x] = 0u;
    __syncthreads();
    const XcdBarrier xbar = xcd_barrier_post((unsigned*)(P.ws + WS_CTL), xst);
#ifndef PHMASK
#define PHMASK 0xFFFF
#endif
    if (PHMASK & 1) for (int rp_ = 0; rp_ < REP_P0; ++rp_) p0_prologue(P, lds);
    grid.sync();
#pragma unroll 1
    for (int l = 0; l < DEPTH; ++l) {
        const size_t wl = (size_t)l * WE_LAYER;
        for (int r1_ = 0; r1_ < REP_G1; ++r1_)
        if (PHMASK & 2) { EpiA E{opq_ws(P.ws), P.sg_ln_g + l * 256, P.sg_ln_b + l * 256};
          GEMM_PHASE(EpiA, H_, W_ + wl + WE_IN, TT, INP, DM, E); }
        GSYNC();
        for (int r2_ = 0; r2_ < REP_G2; ++r2_) {
        if (PHMASK & 4) { EpiQ E{QF_, SSQ_, CS_}; GEMM_PHASE(EpiQ, CQ_, W_ + wl + WE_UQ, TT, 768, QR, E); }
        if (PHMASK & 8) { EpiKV E{KF_, VT_, SSKV_}; GEMM_PHASE(EpiKV, CKV_, W_ + wl + WE_UKV, TT, 1024, KVR, E); }
        }
        GSYNC();
        if (PHMASK & 16) for (int rep_ = 0; rep_ < REP_ATT; ++rep_) attn_phase(lds, QF_, KF_, VT_, MIX_, SSA_);
        GSYNC();
        for (int rl_ = 0; rl_ < REP_LIGHT; ++rl_) if (PHMASK & 32) light_phase(lds, VNT_, W_ + wl + WE_WC, P.b_sp + l * 512, U_, Y_, GB_, P.conv_w + l * 768, SSA_, MIX_);
        GSYNC();
        if (PHMASK & 64) { EpiF<true> E{F_, SSF_, SSA_}; GEMM_PHASE(EpiF<true>, MIX_, W_ + wl + WE_OUT, TT, DM, DM, E); }
        GSYNC();
        if (PHMASK & 128) resid_phase(H_, F_, SSF_, P.mix_post_g + l * DM, WSP(float, WS_RS), nullptr);
        GSYNC();
        if (PHMASK & 256) { EpiGU E{HMID_, WSP(float, WS_RS)}; GEMM_PHASE(EpiGU, H_, W_ + wl + WE_GU, TT, 2 * DFF, DM, E); }
        GSYNC();
        if (PHMASK & 512) { EpiF<false> E{F2_, SSF2_, nullptr}; GEMM_PHASE(EpiF<false>, HMID_, W_ + wl + WE_DN, TT, DM, DFF, E); }
        GSYNC();
        if (PHMASK & 1024) resid_phase(H_, F2_, SSF2_, P.ffn_post_g + l * DM, WSP(float, WS_RS), l + 1 < DEPTH ? nullptr : P.out);
        if (l + 1 < DEPTH) GSYNC();
    }
}

extern "C" void kernel_launch(void* const* d_in, const int* in_sizes, int n_in, void* d_out, int out_size, void* d_ws, size_t ws_size, hipStream_t stream) {
    static int grid = 0;
    if (grid == 0) {
        if (n_in != 21 || out_size != TT * DM || ws_size < WS_END) { fprintf(stderr, "kernel_launch: unexpected problem (n_in %d out %d ws %zu)\n", n_in, out_size, ws_size); grid = -1; return; }
        int dev = 0, cus = 0, per_cu = 0;
        hipGetDevice(&dev); hipDeviceGetAttribute(&cus, hipDeviceAttributeMultiprocessorCount, dev);
        if (hipFuncSetAttribute((const void*)fwd_kernel, hipFuncAttributeMaxDynamicSharedMemorySize, LDS_BYTES) != hipSuccess) { fprintf(stderr, "kernel_launch: hipFuncSetAttribute failed\n"); grid = -1; return; }
        if (hipOccupancyMaxActiveBlocksPerMultiprocessor(&per_cu, (const void*)fwd_kernel, NTHR, LDS_BYTES) != hipSuccess || per_cu < 1) { fprintf(stderr, "kernel_launch: occupancy query gave %d\n", per_cu); per_cu = 1; }
        (void)hipGetLastError();
        grid = cus;
    }
    if (grid < 0) return;
    Params p{};
    p.x = (const float*)d_in[0]; p.pos = (const int*)d_in[1];
    p.mix_pre_g = (const float*)d_in[2]; p.mix_post_g = (const float*)d_in[3]; p.ffn_pre_g = (const float*)d_in[4]; p.ffn_post_g = (const float*)d_in[5];
    p.w_in = (const float*)d_in[6]; p.q_norm_g = (const float*)d_in[7]; p.w_uq = (const float*)d_in[8]; p.kv_norm_g = (const float*)d_in[9]; p.w_ukv = (const float*)d_in[10];
    p.sg_ln_g = (const float*)d_in[11]; p.sg_ln_b = (const float*)d_in[12]; p.w_sp = (const float*)d_in[13]; p.b_sp = (const float*)d_in[14]; p.conv_w = (const float*)d_in[15];
    p.out_norm_g = (const float*)d_in[16]; p.w_out = (const float*)d_in[17]; p.w_gate = (const float*)d_in[18]; p.w_up = (const float*)d_in[19]; p.w_down = (const float*)d_in[20];
    p.out = (float*)d_out; p.ws = (unsigned char*)d_ws;
    for (int i = 0; i < 16; ++i) p.inv_rev[i] = pow(10000.0, -(double)i / 16.0) / 6.283185307179586476925;
    if (hipMemsetAsync((char*)d_ws + WS_CTL, 0, CTL_BYTES, stream) != hipSuccess) { fprintf(stderr, "kernel_launch: memset failed\n"); return; }
    void* args[] = {&p};
    hipError_t e = hipLaunchCooperativeKernel((const void*)fwd_kernel, dim3(grid), dim3(NTHR), args, LDS_BYTES, stream);
    if (e != hipSuccess) fprintf(stderr, "kernel_launch: cooperative launch failed: %s (grid %d)\n", hipGetErrorString(e), grid);
}
```

```cpp
#include <hip/hip_runtime.h>
#include <hip/hip_cooperative_groups.h>
#include <cstdio>
#include <cstdint>
#include <cmath>
namespace cg = cooperative_groups;
namespace pg8 {
#define PG8_LAS __attribute__((address_space(3)))
typedef unsigned short bf16_t;
typedef short bf16x8 __attribute__((ext_vector_type(8)));
typedef float f32x4 __attribute__((ext_vector_type(4)));
typedef unsigned u32x4 __attribute__((ext_vector_type(4)));
constexpr int BM = 256, BK = 64, HALF = 128, HTB = HALF * BK * 2  , STAGE_BYTES = 8 * HTB, NXCD = 8, WGM = 8;

__host__ __device__ __forceinline__ int lds_byte(int r, int c) { const int st = (r >> 4) * 2 + (c >> 5), rr = r & 15, cc = c & 31, ob = rr * 64 + cc * 2; return st * 1024 + (ob ^ (((ob >> 9) & 1) << 5)); }
__host__ __device__ __forceinline__ void stage_rc(int b, int& R, int& C) { const int st = b / 1024, sb = b % 1024, swz = sb ^ (((sb >> 9) & 1) << 5); R = (st >> 1) * 16 + swz / 64; C = (st & 1) * 32 + (swz % 64) / 2; }
__host__ __device__ __forceinline__ int perm32(int rho) { const int n = rho >> 4, i = rho & 15; return 8 * (i >> 2) + 4 * n + (i & 3); }

struct Unit { int pm, pn; };
struct Gemm { const bf16_t* A; const bf16_t* Bt; int M, N, K; };

struct StaticOrder {
    int nM, nN, nwg, G, c;
    __host__ __device__ void init(int M, int N, int G_, int c_) { nM = M / BM; nN = N / BM; nwg = nM * nN; G = G_; c = c_; }
    __host__ __device__ bool next(int i, Unit& u) const {
        const long L = (long)i * G + c; if (L >= nwg) return false;
        int wgid = (int)L; { const int q = nwg / NXCD, r = nwg % NXCD, xcd = wgid % NXCD, off = wgid / NXCD; wgid = (xcd < r ? xcd * (q + 1) : r * (q + 1) + (xcd - r) * q) + off; }
        const int nig = WGM * nN, gid = wgid / nig, fm = gid * WGM, gsz = (nM - fm) < WGM ? (nM - fm) : WGM;
        u.pm = fm + ((wgid % nig) % gsz); u.pn = (wgid % nig) / gsz; return true;
    }
    __device__ __forceinline__ void a_ready(const Unit&) const {}
    __device__ __forceinline__ void done(const Unit&) const {}
};

template <class Epi, class Sched, bool ALIGN_EPI = false, bool SP2 = false>
__device__ __forceinline__ void gemm_phase(PG8_LAS unsigned char* lds, const Gemm g, const Sched& S, const Epi& E) {
    int tid_ = threadIdx.x; asm volatile("" : "+v"(tid_));
    const int tid = tid_, wid = __builtin_amdgcn_readfirstlane(tid >> 6), lane = tid & 63, wr = wid >> 2, wc = wid & 3, fr = lane & 15, fq = lane >> 4;
    const int K = g.K, nt = K / BK;
    unsigned voffA[2], voffB[2];
#pragma unroll
    for (int i = 0; i < 2; ++i) { int R, C; stage_rc(tid * 16 + i * 8192, R, C); const int Rb = Epi::PERM ? ((R & ~31) + perm32(R & 31)) : R;
        voffA[i] = (unsigned)(R * K + C) * 2u; voffB[i] = (unsigned)(Rb * K + C) * 2u; }
    const size_t kstep = (size_t)(BK * 2);
    const size_t hstep = (size_t)HALF * K * 2;
    const size_t tstep = 2 * hstep;
    const unsigned ldsw = (unsigned)wid * 1024u;
    const int aoff = lds_byte(wr * 64 + fr, fq * 8), boff = lds_byte(wc * 32 + fr, fq * 8);
#define PG8_SA(b, h) (((b) * 2 + (h)) * HTB)
#define PG8_SB(b, h) ((4 + (b) * 2 + (h)) * HTB)
#define PG8_STAGE(bufoff, gbase, voff) do { _Pragma("unroll") for (int _i = 0; _i < 2; ++_i) \
        __builtin_amdgcn_global_load_lds((const unsigned*)((const char*)(gbase) + (voff)[_i]), (PG8_LAS unsigned*)(lds + (bufoff) + ldsw + _i * 8192), 16, 0, 0); } while (0)
#define PG8_LDA(dst, b, h) do { _Pragma("unroll") for (int m = 0; m < 4; ++m) _Pragma("unroll") for (int k = 0; k < 2; ++k) dst[m][k] = *(const PG8_LAS bf16x8*)(lds + PG8_SA(b, h) + aoff + m * 2048 + k * 1024); } while (0)
#define PG8_LDB(dst, b, h) do { _Pragma("unroll") for (int n = 0; n < 2; ++n) _Pragma("unroll") for (int k = 0; k < 2; ++k) dst[n][k] = *(const PG8_LAS bf16x8*)(lds + PG8_SB(b, h) + boff + n * 2048 + k * 1024); } while (0)
#define PG8_MMA(ai, bj, At, Bt) do { __builtin_amdgcn_s_setprio(1); _Pragma("unroll") for (int m = 0; m < 4; ++m) _Pragma("unroll") for (int n = 0; n < 2; ++n) _Pragma("unroll") for (int k = 0; k < 2; ++k) \
        acc[ai][bj][m][n] = __builtin_amdgcn_mfma_f32_16x16x32_bf16(Bt[n][k], At[m][k], acc[ai][bj][m][n], 0, 0, 0); __builtin_amdgcn_s_setprio(0); } while (0)
#define PG8_WAIT_V(n) asm volatile("s_waitcnt vmcnt(" #n ")" ::: "memory")
#define PG8_WAIT_L(n) asm volatile("s_waitcnt lgkmcnt(" #n ")" ::: "memory")
#define PG8_BAR __builtin_amdgcn_s_barrier()
#define PG8_SCHED __builtin_amdgcn_sched_barrier(0)
    Unit cur, nxt; int ui = 0;
    if (!S.next(0, cur)) return;
    f32x4 acc[2][2][4][2];
#pragma unroll
    for (int a = 0; a < 2; ++a)
#pragma unroll
        for (int b = 0; b < 2; ++b)
#pragma unroll
            for (int m = 0; m < 4; ++m)
#pragma unroll
                for (int n = 0; n < 2; ++n) acc[a][b][m][n] = (f32x4){0.f, 0.f, 0.f, 0.f};
    bf16x8 At[4][2], B0[2][2], B1[2][2];
    const char* cA = (const char*)g.A + (size_t)cur.pm * tstep; const char* cB = (const char*)g.Bt + (size_t)cur.pn * tstep;
    S.a_ready(cur);
    if constexpr (SP2) {
        PG8_STAGE(PG8_SB(0, 0), cB, voffB); PG8_STAGE(PG8_SB(0, 1), cB + hstep, voffB); PG8_STAGE(PG8_SA(0, 0), cA, voffA); PG8_STAGE(PG8_SA(0, 1), cA + hstep, voffA);
        if (wr == 1) PG8_BAR;
        PG8_WAIT_V(2); PG8_BAR;
        PG8_STAGE(PG8_SB(1, 0), cB + kstep, voffB); PG8_STAGE(PG8_SA(1, 0), cA + kstep, voffA); PG8_STAGE(PG8_SB(1, 1), cB + hstep + kstep, voffB);
        PG8_WAIT_V(6); PG8_BAR;
    } else {
        PG8_STAGE(PG8_SB(0, 0), cB, voffB); PG8_STAGE(PG8_SA(0, 0), cA, voffA); PG8_STAGE(PG8_SB(0, 1), cB + hstep, voffB); PG8_STAGE(PG8_SA(0, 1), cA + hstep, voffA);
        if (wr == 1) PG8_BAR;
        PG8_WAIT_V(4); PG8_BAR;
        PG8_STAGE(PG8_SB(1, 0), cB + kstep, voffB); PG8_STAGE(PG8_SA(1, 0), cA + kstep, voffA); PG8_STAGE(PG8_SB(1, 1), cB + hstep + kstep, voffB);
        PG8_WAIT_V(6); PG8_BAR;
    }
    for (;;) {
        const bool has_next = S.next(ui + 1, nxt);
        const char* nA = has_next ? (const char*)g.A + (size_t)nxt.pm * tstep : cA; const char* nB = has_next ? (const char*)g.Bt + (size_t)nxt.pn * tstep : cB;
        for (int t = 0; t < nt; t += 2) {
            const bool last = (t == nt - 2);
            const char* a1 = cA + (size_t)(t + 1) * kstep;
            const char* a2 = last ? nA : cA + (size_t)(t + 2) * kstep; const char* b2 = last ? nB : cB + (size_t)(t + 2) * kstep;
            const char* a3 = a2 + kstep; const char* b3 = b2 + kstep;
            if (last && has_next) S.a_ready(nxt);
            if constexpr (SP2) {
            PG8_LDB(B0, 0, 0); PG8_LDB(B1, 0, 1); PG8_SCHED; PG8_LDA(At, 0, 0); PG8_STAGE(PG8_SA(1, 1), a1 + hstep, voffA);
            PG8_WAIT_V(8); PG8_WAIT_L(0); PG8_BAR; PG8_MMA(0, 0, At, B0); PG8_MMA(0, 1, At, B1); PG8_BAR; PG8_SCHED;
            PG8_LDA(At, 0, 1); PG8_STAGE(PG8_SB(0, 0), b2, voffB); PG8_STAGE(PG8_SB(0, 1), b2 + hstep, voffB); PG8_STAGE(PG8_SA(0, 0), a2, voffA);
            PG8_WAIT_V(8); PG8_WAIT_L(0); PG8_BAR; PG8_MMA(1, 0, At, B0); PG8_MMA(1, 1, At, B1); PG8_BAR; PG8_SCHED;
            PG8_LDB(B0, 1, 0); PG8_LDB(B1, 1, 1); PG8_SCHED; PG8_LDA(At, 1, 0); PG8_STAGE(PG8_SA(0, 1), a2 + hstep, voffA);
            PG8_WAIT_V(8); PG8_WAIT_L(0); PG8_BAR; PG8_MMA(0, 0, At, B0); PG8_MMA(0, 1, At, B1); PG8_BAR; PG8_SCHED;
            PG8_LDA(At, 1, 1); PG8_STAGE(PG8_SB(1, 0), b3, voffB); PG8_STAGE(PG8_SB(1, 1), b3 + hstep, voffB); PG8_STAGE(PG8_SA(1, 0), a3, voffA);
            PG8_WAIT_V(8); PG8_WAIT_L(0); PG8_BAR; PG8_MMA(1, 0, At, B0); PG8_MMA(1, 1, At, B1); PG8_BAR; PG8_SCHED;
            } else {
            PG8_LDB(B0, 0, 0); PG8_SCHED; PG8_LDA(At, 0, 0); PG8_STAGE(PG8_SA(1, 1), a1 + hstep, voffA);
            PG8_WAIT_L(8); PG8_BAR; PG8_WAIT_L(0); PG8_MMA(0, 0, At, B0); PG8_BAR; PG8_SCHED;
            PG8_LDB(B1, 0, 1); PG8_STAGE(PG8_SB(0, 0), b2, voffB);
            PG8_BAR; PG8_WAIT_L(0); PG8_MMA(0, 1, At, B1); PG8_BAR;
            PG8_LDA(At, 0, 1); PG8_STAGE(PG8_SA(0, 0), a2, voffA);
            PG8_BAR; PG8_WAIT_L(0); PG8_MMA(1, 0, At, B0); PG8_BAR; PG8_SCHED;
            PG8_STAGE(PG8_SB(0, 1), b2 + hstep, voffB);
            PG8_WAIT_V(6); PG8_BAR; PG8_MMA(1, 1, At, B1); PG8_BAR;
            PG8_LDB(B0, 1, 0); PG8_SCHED; PG8_LDA(At, 1, 0); PG8_STAGE(PG8_SA(0, 1), a2 + hstep, voffA);
            PG8_WAIT_L(8); PG8_BAR; PG8_WAIT_L(0); PG8_MMA(0, 0, At, B0); PG8_BAR; PG8_SCHED;
            PG8_LDB(B1, 1, 1); PG8_STAGE(PG8_SB(1, 0), b3, voffB);
            PG8_BAR; PG8_WAIT_L(0); PG8_MMA(0, 1, At, B1); PG8_BAR;
            PG8_LDA(At, 1, 1); PG8_STAGE(PG8_SA(1, 0), a3, voffA);
            PG8_BAR; PG8_WAIT_L(0); PG8_MMA(1, 0, At, B0); PG8_BAR; PG8_SCHED;
            PG8_STAGE(PG8_SB(1, 1), b3 + hstep, voffB);
            PG8_WAIT_V(6); PG8_BAR; PG8_MMA(1, 1, At, B1); PG8_BAR;
            }
        }
        if constexpr (ALIGN_EPI) { if (wr == 0) PG8_BAR; }
        if constexpr (!Epi::AFTER_DRAIN) { E(acc, cur, wr, wc, fr, fq); S.done(cur); }
        if (!has_next) break;
#pragma unroll
        for (int a = 0; a < 2; ++a)
#pragma unroll
            for (int b = 0; b < 2; ++b)
#pragma unroll
                for (int m = 0; m < 4; ++m)
#pragma unroll
                    for (int n = 0; n < 2; ++n) acc[a][b][m][n] = (f32x4){0.f, 0.f, 0.f, 0.f};
        cur = nxt; cA = nA; cB = nB; ++ui;
        if constexpr (ALIGN_EPI) { if (wr == 1) PG8_BAR; }
    }
    PG8_WAIT_V(0);
    if constexpr (!ALIGN_EPI) { if (wr == 0) PG8_BAR; }
    PG8_BAR;
    if constexpr (Epi::AFTER_DRAIN) { E.fused(acc, cur, wr, wc, fr, fq, lds, wid, lane); S.done(cur); }
#undef PG8_SA
#undef PG8_SB
#undef PG8_STAGE
#undef PG8_LDA
#undef PG8_LDB
#undef PG8_MMA
#undef PG8_WAIT_V
#undef PG8_WAIT_L
#undef PG8_BAR
#undef PG8_SCHED
}
}

#define LAS __attribute__((address_space(3)))
typedef unsigned short bf16_t;
typedef short bf16x8 __attribute__((ext_vector_type(8)));
typedef float f32x4 __attribute__((ext_vector_type(4)));
typedef float f32x16 __attribute__((ext_vector_type(16)));
typedef unsigned u32x2 __attribute__((ext_vector_type(2)));
typedef unsigned u32x4 __attribute__((ext_vector_type(4)));

constexpr int DM = 1024, NB = 8, SEQ = 4096, TT = NB * SEQ, DEPTH = 4, NH = 8;
constexpr int QR = 384, KVR = 256, DFF = 2816, INW = 1952, INP = 2048;
constexpr float EPS = 1e-6f;
constexpr float QSCALE = 0.10206207261596575f * 1.4426950408889634f;
constexpr int NWAVES = 8, NTHR = 512;

constexpr size_t MiB = 1u << 20;
constexpr size_t WE_IN = 0, WE_UQ = WE_IN + (size_t)INP * DM, WE_UKV = WE_UQ + (size_t)768 * QR, WE_OUT = WE_UKV + (size_t)1024 * KVR,
                 WE_GU = WE_OUT + (size_t)DM * DM, WE_DN = WE_GU + (size_t)2 * DFF * DM, WE_WC = WE_DN + (size_t)DM * DFF, WE_LAYER = WE_WC + (size_t)4 * 128 * 128;
static_assert(WE_LAYER * 2 * DEPTH <= 96 * MiB, "weights region");
constexpr size_t WS_W = 0, WS_CS = 96 * MiB, WS_SS = 100 * MiB, WS_H = 112 * MiB, WS_R2 = 176 * MiB;
constexpr size_t WS_CTL = 110 * MiB, CTL_BYTES = 16384;
constexpr size_t WS_RS = 111 * MiB;
constexpr size_t SS_STRIDE = 2 * MiB;
constexpr size_t R_CQ = WS_R2, R_CKV = WS_R2 + 24 * MiB, R_U = WS_R2 + 40 * MiB, R_VNT = WS_R2 + 56 * MiB, R_Y = WS_R2 + 72 * MiB, R_GB = WS_R2 + 88 * MiB,
                 R_QF = WS_R2 + 104 * MiB, R_KF = WS_R2 + 152 * MiB, R_VT = WS_R2 + 200 * MiB, R_MIX = WS_R2 + 232 * MiB, WS_END = WS_R2 + 296 * MiB;
constexpr size_t R_F = R_QF, R_HMID = WS_R2, R_F2 = WS_R2 + 176 * MiB;

constexpr int LDS_BYTES = 132 * 1024;

struct Params {
    const float* x; const int* pos;
    const float *mix_pre_g, *mix_post_g, *ffn_pre_g, *ffn_post_g, *w_in, *q_norm_g, *w_uq, *kv_norm_g, *w_ukv, *sg_ln_g, *sg_ln_b, *w_sp, *b_sp, *conv_w,
                *out_norm_g, *w_out, *w_gate, *w_up, *w_down;
    float* out; unsigned char* ws;
    double inv_rev[16];
};

__device__ __forceinline__ unsigned pkbf(float lo, float hi) {
    typedef float f2_t __attribute__((ext_vector_type(2))); typedef __bf16 b2_t __attribute__((ext_vector_type(2)));
    f2_t v = {lo, hi}; b2_t b = __builtin_convertvector(v, b2_t); return __builtin_bit_cast(unsigned, b);
}
__device__ __forceinline__ bf16_t f2bf(float f) { return (bf16_t)(pkbf(f, 0.f) & 0xffffu); }
__device__ __forceinline__ float bflo(unsigned w) { return __uint_as_float(w << 16); }
__device__ __forceinline__ float bfhi(unsigned w) { return __uint_as_float(w & 0xffff0000u); }
__device__ __forceinline__ void store4(bf16_t* p, f32x4 v) { u32x2 w; w.x = pkbf(v[0], v[1]); w.y = pkbf(v[2], v[3]); *(u32x2*)p = w; }
__device__ __forceinline__ f32x4 load4bf(const bf16_t* p) { const u32x2 w = *(const u32x2*)p; return (f32x4){bflo(w.x), bfhi(w.x), bflo(w.y), bfhi(w.y)}; }
__device__ __forceinline__ float wave_sum(float v) {
#pragma unroll
    for (int o = 1; o < 64; o <<= 1) v += __shfl_xor(v, o);
    return v;
}
__device__ __forceinline__ float gelu_tanh(float x) {
    const float u = 0.7978845608028654f * (x + 0.044715f * x * x * x);
    return x * __builtin_amdgcn_rcpf(1.f + __builtin_amdgcn_exp2f(-2.f * 1.4426950408889634f * u));
}
__device__ __forceinline__ float silu_f(float x) { return x * __builtin_amdgcn_rcpf(1.f + __builtin_amdgcn_exp2f(-1.4426950408889634f * x)); }
__device__ __forceinline__ float dot4(f32x4 v) { return (v[0] * v[0] + v[1] * v[1]) + (v[2] * v[2] + v[3] * v[3]); }
__device__ __forceinline__ float sum4(f32x4 v) { return (v[0] + v[1]) + (v[2] + v[3]); }
__device__ __forceinline__ int crow(int r, int hi) { return (r & 3) + 8 * (r >> 2) + 4 * hi; }
__device__ __forceinline__ int opq(int v) { asm volatile("" : "+v"(v)); return v; }
#define TID_OPQ() opq((int)threadIdx.x)

typedef pg8::f32x4 pf4;
#define ACC_T const pf4 (&acc)[2][2][4][2]

struct EpiA {
    static constexpr bool PERM = false, AFTER_DRAIN = false;
    unsigned char* ws; const float *lng, *lnb;
    __device__ __forceinline__ void operator()(ACC_T, const pg8::Unit& u, int wr, int wc, int fr_, int fq_) const {
        const int fr = opq(fr_), fq = opq(fq_);
        bf16_t *CQ = (bf16_t*)(ws + R_CQ), *CKV = (bf16_t*)(ws + R_CKV), *U = (bf16_t*)(ws + R_U), *VNT = (bf16_t*)(ws + R_VNT), *Y = (bf16_t*)(ws + R_Y), *GB = (bf16_t*)(ws + R_GB), *Kf = (bf16_t*)(ws + R_KF);
        float *SSQ = (float*)(ws + WS_SS), *SSKV = (float*)(ws + WS_SS + SS_STRIDE); const float* CS = (const float*)(ws + WS_CS); const float* RS = (const float*)(ws + WS_RS);
        const int rbase = u.pm * 256 + wr * 64 + fr, cl = wc * 32 + 4 * fq;
        if (u.pn == 0 || u.pn == 2) {
            bf16_t* O = u.pn == 0 ? CQ : CKV; const int ld = u.pn == 0 ? QR : KVR; float* SS = u.pn == 0 ? SSQ : SSKV;
#pragma unroll
            for (int ai = 0; ai < 2; ++ai)
#pragma unroll
                for (int m = 0; m < 4; ++m) { const int row = rbase + 128 * ai + 16 * m; float s = 0.f; const float rx = RS[row];
#pragma unroll
                    for (int bj = 0; bj < 2; ++bj)
#pragma unroll
                        for (int n = 0; n < 2; ++n) { const f32x4 v = acc[ai][bj][m][n] * rx; s += dot4(v); store4(O + (size_t)row * ld + 128 * bj + cl + 16 * n, v); }
                    s += __shfl_xor(s, 16); s += __shfl_xor(s, 32);
                    if (fq == 0) SS[(size_t)row * 16 + wc] = s; asm volatile("" ::: "memory"); }
        } else if (u.pn == 1) {
#pragma unroll
            for (int ai = 0; ai < 2; ++ai)
#pragma unroll
                for (int m = 0; m < 4; ++m) { const int row = rbase + 128 * ai + 16 * m; float s = 0.f; const float rx = RS[row];
#pragma unroll
                    for (int n = 0; n < 2; ++n) { const f32x4 v = acc[ai][0][m][n] * rx; s += dot4(v); store4(CQ + (size_t)row * QR + 256 + cl + 16 * n, v); }
                    s += __shfl_xor(s, 16); s += __shfl_xor(s, 32);
                    if (fq == 0) SSQ[(size_t)row * 16 + 4 + wc] = s;
                    if (wc == 0) {
                        const f32x4 t1 = acc[ai][1][m][0] * rx, t2 = acc[ai][1][m][1] * rx;
                        const f32x4 c4 = *(const f32x4*)(CS + (size_t)row * 32 + 4 * fq), s4 = *(const f32x4*)(CS + (size_t)row * 32 + 16 + 4 * fq);
                        const f32x4 o1 = t1 * c4 - t2 * s4, o2 = t2 * c4 + t1 * s4;
                        const int b = row >> 12, sp = row & 4095;
#pragma unroll
                        for (int hd = 0; hd < NH; ++hd) { bf16_t* kp = Kf + ((size_t)(b * NH + hd) * SEQ + sp) * 96 + 64 + 4 * fq; store4(kp, o1); store4(kp + 16, o2); }
                    } asm volatile("" ::: "memory"); }
        } else if (u.pn == 3 || u.pn == 7) {
            bf16_t* O = u.pn == 3 ? U : GB; const bool act = (u.pn == 3);
#pragma unroll
            for (int ai = 0; ai < 2; ++ai)
#pragma unroll
                for (int m = 0; m < 4; ++m) { const int row = rbase + 128 * ai + 16 * m; const float rx = RS[row];
#pragma unroll
                    for (int bj = 0; bj < 2; ++bj)
#pragma unroll
                        for (int n = 0; n < 2; ++n) { f32x4 v = acc[ai][bj][m][n] * rx;
                            if (act) { v[0] = gelu_tanh(v[0]); v[1] = gelu_tanh(v[1]); v[2] = gelu_tanh(v[2]); v[3] = gelu_tanh(v[3]); }
                            store4(O + (size_t)row * 256 + 128 * bj + cl + 16 * n, v); } asm volatile("" ::: "memory"); }
        } else if (u.pn == 4) {
#pragma unroll
            for (int ai = 0; ai < 2; ++ai)
#pragma unroll
                for (int m = 0; m < 4; ++m) { const int row = rbase + 128 * ai + 16 * m; f32x4 g[2][2]; float s = 0.f; const float rx = RS[row];
#pragma unroll
                    for (int bj = 0; bj < 2; ++bj)
#pragma unroll
                        for (int n = 0; n < 2; ++n) { f32x4 v = acc[ai][bj][m][n] * rx; v[0] = gelu_tanh(v[0]); v[1] = gelu_tanh(v[1]); v[2] = gelu_tanh(v[2]); v[3] = gelu_tanh(v[3]); g[bj][n] = v; s += sum4(v); }
                    s += __shfl_xor(s, 16); s += __shfl_xor(s, 32);
                    const float mu = s * (1.f / 64.f); float q = 0.f;
#pragma unroll
                    for (int bj = 0; bj < 2; ++bj)
#pragma unroll
                        for (int n = 0; n < 2; ++n) { g[bj][n] = g[bj][n] - mu; q += dot4(g[bj][n]); }
                    q += __shfl_xor(q, 16); q += __shfl_xor(q, 32);
                    const float rstd = 1.f / sqrtf(q * (1.f / 64.f) + EPS);
                    bf16_t* vb = VNT + ((size_t)((row >> 7) * 4 + wc) * 64) * 128 + (row & 127);
#pragma unroll
                    for (int bj = 0; bj < 2; ++bj)
#pragma unroll
                        for (int n = 0; n < 2; ++n) { const int e = 32 * bj + 16 * n + 4 * fq; const f32x4 gg = *(const f32x4*)(lng + 64 * wc + e), bb = *(const f32x4*)(lnb + 64 * wc + e);
                            const f32x4 o = g[bj][n] * rstd * gg + bb;
#pragma unroll
                            for (int j = 0; j < 4; ++j) vb[(size_t)(e + j) * 128] = f2bf(o[j]); } asm volatile("" ::: "memory"); }
        } else {
            const int cb = 128 * (u.pn - 5) + cl;
#pragma unroll
            for (int ai = 0; ai < 2; ++ai)
#pragma unroll
                for (int m = 0; m < 4; ++m) { const int row = rbase + 128 * ai + 16 * m; const float rx = RS[row], rx2 = rx * rx;
#pragma unroll
                    for (int n = 0; n < 2; ++n) store4(Y + (size_t)row * 256 + cb + 16 * n, acc[ai][0][m][n] * acc[ai][1][m][n] * rx2); asm volatile("" ::: "memory"); }
        }
    }
};

struct EpiQ {
    static constexpr bool PERM = false, AFTER_DRAIN = false;
    bf16_t* Qf; const float* SSQ; const float* CS;
    __device__ __forceinline__ void operator()(ACC_T, const pg8::Unit& u, int wr, int wc, int fr_, int fq_) const {
        const int fr = opq(fr_), fq = opq(fq_);
        const int rbase = u.pm * 256 + wr * 64 + fr;
#pragma unroll
        for (int ai = 0; ai < 2; ++ai)
#pragma unroll
            for (int m = 0; m < 4; ++m) { const int row = rbase + 128 * ai + 16 * m;
                const f32x4 sa = *(const f32x4*)(SSQ + (size_t)row * 16), sb = *(const f32x4*)(SSQ + (size_t)row * 16 + 4);
                const float rs = QSCALE / sqrtf((sum4(sa) + sum4(sb)) * (1.f / QR) + EPS);
                const int b = row >> 12, sp = row & 4095;
#pragma unroll
                for (int bj = 0; bj < 2; ++bj) { const int p = 8 * u.pn + 4 * bj + wc, head = p / 3, part = p - 3 * head;
                    bf16_t* base = Qf + ((size_t)(b * NH + head) * SEQ + sp) * 96;
                    if (part < 2) {
#pragma unroll
                        for (int n = 0; n < 2; ++n) store4(base + 32 * part + 16 * n + 4 * fq, acc[ai][bj][m][n] * rs);
                    } else {
                        const f32x4 t1 = acc[ai][bj][m][0] * rs, t2 = acc[ai][bj][m][1] * rs;
                        const f32x4 c4 = *(const f32x4*)(CS + (size_t)row * 32 + 4 * fq), s4 = *(const f32x4*)(CS + (size_t)row * 32 + 16 + 4 * fq);
                        store4(base + 64 + 4 * fq, t1 * c4 - t2 * s4); store4(base + 80 + 4 * fq, t2 * c4 + t1 * s4);
                    } } asm volatile("" ::: "memory"); }
    }
};

struct EpiKV {
    static constexpr bool PERM = false, AFTER_DRAIN = false;
    bf16_t *Kf, *Vt; const float* SSKV;
    __device__ __forceinline__ void operator()(ACC_T, const pg8::Unit& u, int wr, int wc, int fr_, int fq_) const {
        const int fr = opq(fr_), fq = opq(fq_);
        const int rbase = u.pm * 256 + wr * 64 + fr;
#pragma unroll
        for (int ai = 0; ai < 2; ++ai)
#pragma unroll
            for (int m = 0; m < 4; ++m) { const int row = rbase + 128 * ai + 16 * m;
                const f32x4 sa = *(const f32x4*)(SSKV + (size_t)row * 16);
                const float rs = 1.f / sqrtf(sum4(sa) * (1.f / KVR) + EPS);
                const int b = row >> 12, sp = row & 4095;
#pragma unroll
                for (int bj = 0; bj < 2; ++bj) { const int p = 8 * u.pn + 4 * bj + wc, head = p >> 2, part = p & 3;
                    if (part < 2) { bf16_t* base = Kf + ((size_t)(b * NH + head) * SEQ + sp) * 96 + 32 * part + 4 * fq;
#pragma unroll
                        for (int n = 0; n < 2; ++n) store4(base + 16 * n, acc[ai][bj][m][n] * rs);
                    } else { bf16_t* base = Vt + ((size_t)(b * NH + head) * 64 + 32 * (part - 2) + 4 * fq) * SEQ + sp;
#pragma unroll
                        for (int n = 0; n < 2; ++n) { const f32x4 v = acc[ai][bj][m][n] * rs;
#pragma unroll
                            for (int j = 0; j < 4; ++j) base[(size_t)(16 * n + j) * SEQ] = f2bf(v[j]); } } } asm volatile("" ::: "memory"); }
    }
};

template <bool ROWSCALE> struct EpiF {
    static constexpr bool PERM = true, AFTER_DRAIN = false;
    bf16_t* F; float* SS; const float* SSA;
    __device__ __forceinline__ void operator()(ACC_T, const pg8::Unit& u, int wr, int wc, int fr_, int fq_) const {
        const int fr = opq(fr_), fq = opq(fq_);
        const int rbase = u.pm * 256 + wr * 64 + fr, cl = u.pn * 256 + wc * 32 + 8 * fq;
#pragma unroll
        for (int ai = 0; ai < 2; ++ai)
#pragma unroll
            for (int m = 0; m < 4; ++m) { const int row = rbase + 128 * ai + 16 * m; float s = 0.f; float ra = 1.f;
                if (ROWSCALE) { const float* sp = SSA + (size_t)row * 16; ra = __builtin_amdgcn_rsqf((sum4(*(const f32x4*)sp) + sum4(*(const f32x4*)(sp + 4))) * (1.f / 512.f) + EPS); }
#pragma unroll
                for (int bj = 0; bj < 2; ++bj) { const f32x4 v0 = acc[ai][bj][m][0] * ra, v1 = acc[ai][bj][m][1] * ra; s += dot4(v0) + dot4(v1);
                    u32x4 w; w.x = pkbf(v0[0], v0[1]); w.y = pkbf(v0[2], v0[3]); w.z = pkbf(v1[0], v1[1]); w.w = pkbf(v1[2], v1[3]);
                    *(u32x4*)(F + (size_t)row * DM + 128 * bj + cl) = w; }
                s += __shfl_xor(s, 16); s += __shfl_xor(s, 32);
                if (fq == 0) SS[(size_t)row * 16 + 4 * u.pn + wc] = s; asm volatile("" ::: "memory"); }
    }
};

struct EpiGU {
    static constexpr bool PERM = true, AFTER_DRAIN = false;
    bf16_t* HM; const float* RS;
    __device__ __forceinline__ void operator()(ACC_T, const pg8::Unit& u, int wr, int wc, int fr_, int fq_) const {
        const int fr = opq(fr_), fq = opq(fq_);
        const int rbase = u.pm * 256 + wr * 64 + fr, cb = u.pn * 128 + wc * 32 + 8 * fq;
#pragma unroll
        for (int ai = 0; ai < 2; ++ai)
#pragma unroll
            for (int m = 0; m < 4; ++m) { const int row = rbase + 128 * ai + 16 * m; const float rx = RS[row]; float o[8];
#pragma unroll
                for (int n = 0; n < 2; ++n) { const f32x4 g = acc[ai][0][m][n] * rx, up = acc[ai][1][m][n] * rx;
#pragma unroll
                    for (int j = 0; j < 4; ++j) o[4 * n + j] = silu_f(g[j]) * up[j]; }
                u32x4 w; w.x = pkbf(o[0], o[1]); w.y = pkbf(o[2], o[3]); w.z = pkbf(o[4], o[5]); w.w = pkbf(o[6], o[7]);
                *(u32x4*)(HM + (size_t)row * DFF + cb) = w; asm volatile("" ::: "memory"); }
    }
};

__device__ __forceinline__ void conv_item(const float* src, int ldsrc, const float* gain, int k0, bf16_t* dst, int K, LAS float* scr, int lane) {
    float v[32];
    if (src) { const float* sp = src + (size_t)(k0 + (lane >> 5)) * ldsrc + (lane & 31);
#pragma unroll
        for (int i = 0; i < 32; ++i) v[i] = sp[(size_t)(2 * i) * ldsrc];
    } else {
#pragma unroll
        for (int i = 0; i < 32; ++i) v[i] = 0.f;
    }
#pragma unroll
    for (int i = 0; i < 32; ++i) scr[(2 * i + (lane >> 5)) * 33 + (lane & 31)] = v[i];
    asm volatile("s_waitcnt lgkmcnt(0)" ::: "memory");
    const int c = lane & 7;
    f32x4 g0 = (f32x4){1.f, 1.f, 1.f, 1.f}, g1 = g0;
    if (gain) { g0 = *(const f32x4*)(gain + k0 + 8 * c); g1 = *(const f32x4*)(gain + k0 + 8 * c + 4); }
#pragma unroll
    for (int j = 0; j < 4; ++j) { const int n = (lane >> 3) + 8 * j; const LAS float* t = scr + (8 * c) * 33 + n;
        u32x4 o; o.x = pkbf(t[0 * 33] * g0[0], t[1 * 33] * g0[1]); o.y = pkbf(t[2 * 33] * g0[2], t[3 * 33] * g0[3]); o.z = pkbf(t[4 * 33] * g1[0], t[5 * 33] * g1[1]); o.w = pkbf(t[6 * 33] * g1[2], t[7 * 33] * g1[3]);
        *(u32x4*)(dst + (size_t)n * K + k0 + 8 * c) = o; }
    asm volatile("s_waitcnt lgkmcnt(0)" ::: "memory");
}
__device__ __forceinline__ int zcol_of_block(int nb) {
    const int tile = nb >> 3, q = nb & 7;
    switch (tile) {
        case 0: return 32 * nb;
        case 1: return q < 4 ? 256 + 32 * q : (q == 4 ? 640 : -1);
        case 2: return 384 + 32 * q;
        case 3: return 672 + 32 * q;
        case 4: return 928 + 64 * (q & 3) + 32 * (q >> 2);
        case 5: return q < 4 ? 1440 + 32 * q : 1696 + 32 * (q - 4);
        case 6: return q < 4 ? 1568 + 32 * q : 1824 + 32 * (q - 4);
        default: return 1184 + 32 * q;
    }
}
constexpr int IT_IN = 64 * 16, IT_UQ = 24 * 6, IT_UKV = 32 * 4, IT_OUT = 32 * 16, IT_GU = 176 * 16, IT_DN = 32 * 44, IT_LAYER = IT_IN + IT_UQ + IT_UKV + IT_OUT + IT_GU + IT_DN;

__device__ __forceinline__ void p0_prologue(const Params& P, LAS unsigned char* lds) {
    const int tid = TID_OPQ(), lane = tid & 63, wid = tid >> 6;
    const int gw = blockIdx.x * NWAVES + wid, NGW = gridDim.x * NWAVES;
    LAS float* scr = (LAS float*)(lds + wid * 16384);
    bf16_t* W = (bf16_t*)(P.ws + WS_W);
    for (int it = gw; it < IT_LAYER * DEPTH; it += NGW) {
        const int l = it / IT_LAYER; int r = it - l * IT_LAYER; bf16_t* Wl = W + (size_t)l * WE_LAYER;
        if (r < IT_IN) { const int nb = r >> 4, kb = r & 15, zc = zcol_of_block(nb);
            conv_item(zc >= 0 ? P.w_in + (size_t)l * DM * INW + zc : nullptr, INW, P.mix_pre_g + l * DM, 64 * kb, Wl + WE_IN + (size_t)(32 * nb) * DM, DM, scr, lane); continue; } r -= IT_IN;
        if (r < IT_UQ) { const int nb = r / 6, kb = r - 6 * nb;
            conv_item(P.w_uq + (size_t)l * QR * 768 + 32 * nb, 768, P.q_norm_g + l * QR, 64 * kb, Wl + WE_UQ + (size_t)(32 * nb) * QR, QR, scr, lane); continue; } r -= IT_UQ;
        if (r < IT_UKV) { const int nb = r >> 2, kb = r & 3;
            conv_item(P.w_ukv + (size_t)l * KVR * 1024 + 32 * nb, 1024, P.kv_norm_g + l * KVR, 64 * kb, Wl + WE_UKV + (size_t)(32 * nb) * KVR, KVR, scr, lane); continue; } r -= IT_UKV;
        if (r < IT_OUT) { const int nb = r >> 4, kb = r & 15;
            conv_item(P.w_out + (size_t)l * DM * DM + 32 * nb, DM, P.out_norm_g + l * DM, 64 * kb, Wl + WE_OUT + (size_t)(32 * nb) * DM, DM, scr, lane); continue; } r -= IT_OUT;
        if (r < IT_GU) { const int nb = r >> 4, kb = r & 15, tile = nb >> 3, q = nb & 7;
            const float* src = (q < 4 ? P.w_gate : P.w_up) + (size_t)l * DM * DFF + 128 * tile + 32 * (q & 3);
            conv_item(src, DFF, P.ffn_pre_g + l * DM, 64 * kb, Wl + WE_GU + (size_t)(32 * nb) * DM, DM, scr, lane); continue; } r -= IT_GU;
        { const int nb = r / 44, kb = r - 44 * nb;
            conv_item(P.w_down + (size_t)l * DFF * DM + 32 * nb, DM, nullptr, 64 * kb, Wl + WE_DN + (size_t)(32 * nb) * DFF, DFF, scr, lane); }
    }
    const int gt = blockIdx.x * NTHR + tid, NGT = gridDim.x * NTHR;
    for (int i = gt; i < DEPTH * 4 * 128 * 128; i += NGT) { const int l = i >> 16, rem = i & 65535, t = (rem >> 7) & 127, s = rem & 127;
        W[(size_t)l * WE_LAYER + WE_WC + rem] = (s <= t) ? f2bf(P.w_sp[i]) : (bf16_t)0; }
    float* CS = (float*)(P.ws + WS_CS);
    for (int i = gt; i < TT * 16; i += NGT) { const int row = i >> 4, k = i & 15; const double rev = (double)P.pos[row] * P.inv_rev[k]; const float fr = (float)(rev - rint(rev));
        CS[(size_t)row * 32 + k] = __builtin_amdgcn_cosf(fr); CS[(size_t)row * 32 + 16 + k] = __builtin_amdgcn_sinf(fr); }
    bf16_t* H = (bf16_t*)(P.ws + WS_H); float* RSp = (float*)(P.ws + WS_RS);
    for (int row = 2 * gw; row < TT; row += 2 * NGW) { f32x4 v[2][4]; float ssq[2];
#pragma unroll
        for (int i = 0; i < 2; ++i) { const float* xr = P.x + (size_t)(row + i) * DM + 4 * lane;
#pragma unroll
            for (int j = 0; j < 4; ++j) v[i][j] = *(const f32x4*)(xr + 256 * j); }
#pragma unroll
        for (int i = 0; i < 2; ++i) ssq[i] = (dot4(v[i][0]) + dot4(v[i][1])) + (dot4(v[i][2]) + dot4(v[i][3]));
#pragma unroll
        for (int o = 1; o < 64; o <<= 1) { ssq[0] += __shfl_xor(ssq[0], o); ssq[1] += __shfl_xor(ssq[1], o); }
#pragma unroll
        for (int i = 0; i < 2; ++i) { if (lane == 0) RSp[row + i] = 1.f / sqrtf(ssq[i] * (1.f / DM) + EPS);
#pragma unroll
            for (int j = 0; j < 4; ++j) store4(H + (size_t)(row + i) * DM + 4 * lane + 256 * j, v[i][j]); } }
}

__device__ __forceinline__ void resid_phase(bf16_t* XB, const bf16_t* F, const float* SS, const float* gpost, float* RS, float* outf) {
    const int tid = TID_OPQ(), lane = tid & 63, wid = tid >> 6;
    const int gw = blockIdx.x * NWAVES + wid, NGW = gridDim.x * NWAVES;
    f32x4 g4[4];
#pragma unroll
    for (int j = 0; j < 4; ++j) g4[j] = *(const f32x4*)(gpost + 4 * lane + 256 * j);
    for (int row = 2 * gw; row < TT; row += 2 * NGW) {
        f32x4 v[2][4], f[2][4]; float rs[2], s2[2];
#pragma unroll
        for (int i = 0; i < 2; ++i) { const float* sp = SS + (size_t)(row + i) * 16;
            rs[i] = (sum4(*(const f32x4*)sp) + sum4(*(const f32x4*)(sp + 4))) + (sum4(*(const f32x4*)(sp + 8)) + sum4(*(const f32x4*)(sp + 12)));
#pragma unroll
            for (int j = 0; j < 4; ++j) { const size_t o = (size_t)(row + i) * DM + 4 * lane + 256 * j; v[i][j] = load4bf(XB + o); f[i][j] = load4bf(F + o); } }
#pragma unroll
        for (int i = 0; i < 2; ++i) { const float r = 1.f / sqrtf(rs[i] * (1.f / DM) + EPS); s2[i] = 0.f;
#pragma unroll
            for (int j = 0; j < 4; ++j) { v[i][j] = v[i][j] + f[i][j] * r * g4[j]; s2[i] += dot4(v[i][j]); } }
        if (outf) {
#pragma unroll
            for (int i = 0; i < 2; ++i)
#pragma unroll
                for (int j = 0; j < 4; ++j) *(f32x4*)(outf + (size_t)(row + i) * DM + 4 * lane + 256 * j) = v[i][j];
        } else {
#pragma unroll
            for (int i = 0; i < 2; ++i)
#pragma unroll
                for (int j = 0; j < 4; ++j) store4(XB + (size_t)(row + i) * DM + 4 * lane + 256 * j, v[i][j]);
#pragma unroll
            for (int o = 1; o < 64; o <<= 1) { s2[0] += __shfl_xor(s2[0], o); s2[1] += __shfl_xor(s2[1], o); }
            if (lane < 2) RS[row + lane] = 1.f / sqrtf((lane == 0 ? s2[0] : s2[1]) * (1.f / DM) + EPS);
        }
    }
}

constexpr int KSTR = 208, VSTR = 136, KBUF = 64 * KSTR, VBUF = 64 * VSTR;
constexpr int LDS_K0 = 0, LDS_V0 = 2 * KBUF;
#define MFMA32(a, b, c) __builtin_amdgcn_mfma_f32_32x32x16_bf16((a), (b), (c), 0, 0, 0)
__device__ __forceinline__ float max3f(float a, float b, float c) { float r; asm("v_max3_f32 %0, %1, %2, %3" : "=v"(r) : "v"(a), "v"(b), "v"(c)); return r; }
typedef float f32x2 __attribute__((ext_vector_type(2)));

__device__ __forceinline__ void attn_unit(LAS unsigned char* lds, int bh, int qb, const bf16_t* Qf, const bf16_t* Kf, const bf16_t* Vt, bf16_t* MIX, float* SSA) {
    const int tid = TID_OPQ(), lane = tid & 63, wid = __builtin_amdgcn_readfirstlane(tid >> 6), r32 = lane & 31, hi = lane >> 5;
    const bf16_t* Kh = Kf + (size_t)bh * SEQ * 96; const bf16_t* Vh = Vt + (size_t)bh * 64 * SEQ; const bf16_t* Qh = Qf + (size_t)bh * SEQ * 96;
    const int q0 = qb * 256, NT = 4 * qb + 4;
    bf16x8 qf[6];
    { const bf16_t* qp = Qh + (size_t)(q0 + 32 * wid + r32) * 96 + 8 * hi;
#pragma unroll
      for (int ks = 0; ks < 6; ++ks) qf[ks] = *(const bf16x8*)(qp + 16 * ks); }
    const int kr0 = tid / 12, kc0 = tid - 12 * kr0, i1 = 512 + tid, kr1 = i1 / 12, kc1 = i1 - 12 * kr1;
    const int kl0 = kr0 * KSTR + kc0 * 16, kl1 = kr1 * KSTR + kc1 * 16;
    const int vl = (tid >> 3) * VSTR + (tid & 7) * 16;
    const bf16_t* kg = Kh + (size_t)tid * 8; const bf16_t* vg = Vh + (size_t)(tid >> 3) * SEQ + (tid & 7) * 8;
    u32x4 kreg0, kreg1 = (u32x4){0u, 0u, 0u, 0u}, vreg;
#define ATT_LOAD(t) do { kreg0 = *(const u32x4*)(kg + (size_t)(t) * 64 * 96); if (tid < 256) kreg1 = *(const u32x4*)(kg + (size_t)(t) * 64 * 96 + 512 * 8); vreg = *(const u32x4*)(vg + (t) * 64); } while (0)
#define ATT_STORE(buf) do { *(LAS u32x4*)(lds + LDS_K0 + (buf) * KBUF + kl0) = kreg0; if (tid < 256) *(LAS u32x4*)(lds + LDS_K0 + (buf) * KBUF + kl1) = kreg1; \
        *(LAS u32x2*)(lds + LDS_V0 + (buf) * VBUF + vl) = (u32x2){vreg.x, vreg.y}; *(LAS u32x2*)(lds + LDS_V0 + (buf) * VBUF + vl + 8) = (u32x2){vreg.z, vreg.w}; } while (0)
    f32x16 o0, o1;
#pragma unroll
    for (int r = 0; r < 16; ++r) { o0[r] = 0.f; o1[r] = 0.f; }
    float mrun = 0.f, lrun = 0.f;
    f32x16 negm;
#pragma unroll
    for (int r = 0; r < 16; ++r) negm[r] = 0.f;
    const int qrel = 32 * wid + r32;
    ATT_LOAD(0); ATT_STORE(0); __syncthreads();
    for (int t = 0; t < NT; ++t) {
        const int buf = t & 1;
        if (t + 1 < NT) ATT_LOAD(t + 1);
        const int jb = t - (NT - 4);
        if (jb <= (wid >> 1)) {
            f32x16 p0, p1;
            const LAS unsigned char* kb = lds + LDS_K0 + buf * KBUF + r32 * KSTR + 16 * hi;
#pragma unroll
            for (int ks = 0; ks < 6; ++ks) { const bf16x8 a0 = *(const LAS bf16x8*)(kb + 32 * ks), a1 = *(const LAS bf16x8*)(kb + 32 * KSTR + 32 * ks);
                if (ks == 0) { p0 = MFMA32(a0, qf[0], negm); p1 = MFMA32(a1, qf[0], negm); }
                else { p0 = MFMA32(a0, qf[ks], p0); p1 = MFMA32(a1, qf[ks], p1); } }
            if (jb >= 0) {
#pragma unroll
                for (int r = 0; r < 16; ++r) { const int kv = 64 * jb + crow(r, hi); if (kv > qrel) p0[r] = -1e30f; if (kv + 32 > qrel) p1[r] = -1e30f; }
            }
            float ma = max3f(p0[0], p0[1], p1[0]), mb = max3f(p0[2], p0[3], p1[1]); ma = max3f(ma, p1[2], p1[3]);
#pragma unroll
            for (int r = 4; r < 16; r += 4) { ma = max3f(ma, p0[r], p0[r + 1]); mb = max3f(mb, p0[r + 2], p0[r + 3]); ma = max3f(ma, p1[r], p1[r + 1]); mb = max3f(mb, p1[r + 2], p1[r + 3]); }
            float mx = fmaxf(ma, mb);
            mx = fmaxf(mx, __shfl_xor(mx, 32));
            if (t == 0 || __any(mx > 0.f)) {
                const float dl = (t == 0) ? mx : fmaxf(mx, 0.f), alpha = __builtin_amdgcn_exp2f(-dl); mrun += dl; lrun *= alpha;
#pragma unroll
                for (int r = 0; r < 16; ++r) { p0[r] -= dl; p1[r] -= dl; o0[r] *= alpha; o1[r] *= alpha; negm[r] = -mrun; }
            }
            f32x2 ls2 = (f32x2){0.f, 0.f};
#pragma unroll
            for (int r = 0; r < 16; ++r) { p0[r] = __builtin_amdgcn_exp2f(p0[r]); p1[r] = __builtin_amdgcn_exp2f(p1[r]); }
#pragma unroll
            for (int r = 0; r < 16; r += 2) { ls2 += (f32x2){p0[r], p0[r + 1]}; ls2 += (f32x2){p1[r], p1[r + 1]}; }
            lrun += ls2.x + ls2.y;
            bf16x8 pf[4];
#pragma unroll
            for (int s = 0; s < 2; ++s) { u32x4 w0, w1;
                w0.x = pkbf(p0[8 * s], p0[8 * s + 1]); w0.y = pkbf(p0[8 * s + 2], p0[8 * s + 3]); w0.z = pkbf(p0[8 * s + 4], p0[8 * s + 5]); w0.w = pkbf(p0[8 * s + 6], p0[8 * s + 7]);
                w1.x = pkbf(p1[8 * s], p1[8 * s + 1]); w1.y = pkbf(p1[8 * s + 2], p1[8 * s + 3]); w1.z = pkbf(p1[8 * s + 4], p1[8 * s + 5]); w1.w = pkbf(p1[8 * s + 6], p1[8 * s + 7]);
                pf[s] = __builtin_bit_cast(bf16x8, w0); pf[2 + s] = __builtin_bit_cast(bf16x8, w1); }
            const LAS unsigned char* vb = lds + LDS_V0 + buf * VBUF + r32 * VSTR + 8 * hi;
#pragma unroll
            for (int pb = 0; pb < 2; ++pb)
#pragma unroll
                for (int s = 0; s < 2; ++s) { const int off = (32 * pb + 16 * s) * 2;
                    const u32x2 a_lo = *(const LAS u32x2*)(vb + off), a_hi = *(const LAS u32x2*)(vb + off + 16);
                    const u32x2 b_lo = *(const LAS u32x2*)(vb + 32 * VSTR + off), b_hi = *(const LAS u32x2*)(vb + 32 * VSTR + off + 16);
                    const bf16x8 va = __builtin_bit_cast(bf16x8, (u32x4){a_lo.x, a_lo.y, a_hi.x, a_hi.y}), vbb = __builtin_bit_cast(bf16x8, (u32x4){b_lo.x, b_lo.y, b_hi.x, b_hi.y});
                    o0 = MFMA32(va, pf[2 * pb + s], o0); o1 = MFMA32(vbb, pf[2 * pb + s], o1); }
        }
        if (t + 1 < NT) ATT_STORE(buf ^ 1);
        __syncthreads();
    }
#undef ATT_LOAD
#undef ATT_STORE
    const float ltot = lrun + __shfl_xor(lrun, 32), inv = 1.f / ltot;
    float ss = 0.f;
#pragma unroll
    for (int r = 0; r < 16; ++r) { o0[r] *= inv; o1[r] *= inv; ss += o0[r] * o0[r] + o1[r] * o1[r]; }
    ss += __shfl_xor(ss, 32);
    const int b = bh >> 3, h = bh & 7; const size_t row = (size_t)b * SEQ + q0 + 32 * wid + r32;
    if (hi == 0) SSA[row * 16 + h] = ss;
    bf16_t* op = MIX + row * DM + h * 64 + 4 * hi;
#pragma unroll
    for (int g4 = 0; g4 < 4; ++g4) { store4(op + 8 * g4, (f32x4){o0[4 * g4], o0[4 * g4 + 1], o0[4 * g4 + 2], o0[4 * g4 + 3]});
        store4(op + 32 + 8 * g4, (f32x4){o1[4 * g4], o1[4 * g4 + 1], o1[4 * g4 + 2], o1[4 * g4 + 3]}); }
}
__device__ __forceinline__ void attn_phase(LAS unsigned char* lds, const bf16_t* Qf, const bf16_t* Kf, const bf16_t* Vt, bf16_t* MIX, float* SSA) {
    const int G = gridDim.x, bx = blockIdx.x; const int vcu = (G % 8 == 0) ? (bx % 8) * (G / 8) + bx / 8 : bx;
    for (int w = vcu; w < 256; w += G) { const int bh = w >> 2, s4 = w & 3;
#pragma unroll 1
        for (int i = 0; i < 4; ++i) { const int qb = (i == 0) ? 15 - s4 : (i == 1) ? 8 + s4 : (i == 2) ? 7 - s4 : s4; attn_unit(lds, bh, qb, Qf, Kf, Vt, MIX, SSA); } }
}

__device__ __forceinline__ void sgu_unit(LAS unsigned char* lds, int chunk, const bf16_t* VNT, const bf16_t* WC, const float* bsp, const bf16_t* U, const float* SSA, bf16_t* MIX) {
    const int tid = TID_OPQ(), lane = tid & 63, wid = __builtin_amdgcn_readfirstlane(tid >> 6), r32 = lane & 31, hi = lane >> 5;
    const int g = wid >> 1, th = wid & 1;
    LAS float* red = (LAS float*)lds;
    const bf16_t* ap = VNT + ((size_t)(chunk * 4 + g) * 64 + r32) * 128 + 8 * hi;
    const bf16_t* bp = WC + ((size_t)g * 128 + 64 * th + r32) * 128 + 8 * hi;
    f32x16 acc[2][2];
#pragma unroll
    for (int a = 0; a < 2; ++a)
#pragma unroll
        for (int b = 0; b < 2; ++b)
#pragma unroll
            for (int r = 0; r < 16; ++r) acc[a][b][r] = 0.f;
#pragma unroll
    for (int ks = 0; ks < 8; ++ks) {
        const bf16x8 a0 = *(const bf16x8*)(ap + 16 * ks), a1 = *(const bf16x8*)(ap + 32 * 128 + 16 * ks);
        const bf16x8 b0 = *(const bf16x8*)(bp + 16 * ks), b1 = *(const bf16x8*)(bp + 32 * 128 + 16 * ks);
        acc[0][0] = MFMA32(a0, b0, acc[0][0]); acc[0][1] = MFMA32(a0, b1, acc[0][1]); acc[1][0] = MFMA32(a1, b0, acc[1][0]); acc[1][1] = MFMA32(a1, b1, acc[1][1]);
    }
#pragma unroll
    for (int tb = 0; tb < 2; ++tb) { const int t = 64 * th + 32 * tb + r32; const size_t row = (size_t)chunk * 128 + t; const float bias = bsp[g * 128 + t]; float ss = 0.f;
#pragma unroll
        for (int eb = 0; eb < 2; ++eb)
#pragma unroll
            for (int g4 = 0; g4 < 4; ++g4) { const f32x4 uu = load4bf(U + row * 256 + g * 64 + 32 * eb + 8 * g4 + 4 * hi);
#pragma unroll
                for (int j = 0; j < 4; ++j) { const float v = uu[j] * (acc[eb][tb][4 * g4 + j] + bias); acc[eb][tb][4 * g4 + j] = v; ss += v * v; } }
        ss += __shfl_xor(ss, 32);
        if (hi == 0) red[g * 128 + t] = ss; }
    __syncthreads();
#pragma unroll
    for (int tb = 0; tb < 2; ++tb) { const int t = 64 * th + 32 * tb + r32; const size_t row = (size_t)chunk * 128 + t;
        const float* sa = SSA + row * 16; const float rai = sqrtf((sum4(*(const f32x4*)sa) + sum4(*(const f32x4*)(sa + 4))) * (1.f / 512.f) + EPS);
        const float tot = (red[t] + red[128 + t]) + (red[256 + t] + red[384 + t]); const float rs = rai / sqrtf(tot * (1.f / 256.f) + EPS);
#pragma unroll
        for (int eb = 0; eb < 2; ++eb)
#pragma unroll
            for (int g4 = 0; g4 < 4; ++g4) store4(MIX + row * DM + 512 + g * 64 + 32 * eb + 8 * g4 + 4 * hi,
                (f32x4){acc[eb][tb][4 * g4] * rs, acc[eb][tb][4 * g4 + 1] * rs, acc[eb][tb][4 * g4 + 2] * rs, acc[eb][tb][4 * g4 + 3] * rs}); }
    __syncthreads();
}
__device__ __forceinline__ void light_phase(LAS unsigned char* lds, const bf16_t* VNT, const bf16_t* WC, const float* bsp, const bf16_t* U, const bf16_t* Y, const bf16_t* GB,
                                            const float* cw, const float* SSA, bf16_t* MIX) {
    for (int c = blockIdx.x; c < TT / 128; c += gridDim.x) sgu_unit(lds, c, VNT, WC, bsp, U, SSA, MIX);
    const int tid = TID_OPQ(), lane = tid & 63, wid = tid >> 6;
    const int gw = blockIdx.x * NWAVES + wid, NGW = gridDim.x * NWAVES;
    const f32x4 w0 = *(const f32x4*)(cw + 4 * lane), w1 = *(const f32x4*)(cw + 256 + 4 * lane), w2 = *(const f32x4*)(cw + 512 + 4 * lane);
    for (int r0 = 8 * gw; r0 < TT; r0 += 8 * NGW) { const bool first = (r0 & 4095) == 0; f32x4 y[10], gb[8], yc[8]; float ss[8];
        y[0] = first ? (f32x4){0.f, 0.f, 0.f, 0.f} : load4bf(Y + (size_t)(r0 - 2) * 256 + 4 * lane);
        y[1] = first ? (f32x4){0.f, 0.f, 0.f, 0.f} : load4bf(Y + (size_t)(r0 - 1) * 256 + 4 * lane);
#pragma unroll
        for (int i = 0; i < 8; ++i) { y[i + 2] = load4bf(Y + (size_t)(r0 + i) * 256 + 4 * lane); gb[i] = load4bf(GB + (size_t)(r0 + i) * 256 + 4 * lane); }
#pragma unroll
        for (int i = 0; i < 8; ++i) { yc[i] = gb[i] * (y[i] * w0 + y[i + 1] * w1 + y[i + 2] * w2); ss[i] = dot4(yc[i]); }
#pragma unroll
        for (int o = 1; o < 64; o <<= 1) {
#pragma unroll
            for (int i = 0; i < 8; ++i) ss[i] += __shfl_xor(ss[i], o); }
#pragma unroll
        for (int i = 0; i < 8; ++i) { const float* sa = SSA + (size_t)(r0 + i) * 16; const float rai = sqrtf((sum4(*(const f32x4*)sa) + sum4(*(const f32x4*)(sa + 4))) * (1.f / 512.f) + EPS);
            store4(MIX + (size_t)(r0 + i) * DM + 768 + 4 * lane, yc[i] * (rai / sqrtf(ss[i] * (1.f / 256.f) + EPS))); } }
}

#define XB_TMO      128
#define XB_XCNT(j)  (256  + 64 * (j))
#define XB_XSUB(j)  (1280 + 64 * (j))
#define XB_XGEN(j)  (2304 + 64 * (j))
#define XB_TOP      3328
#define XB_TOPGEN   3392
#define XCD_BAR_WORDS 3456
#define XB_SPIN_CAP (1u << 18)

__device__ __forceinline__ unsigned xb_ld(unsigned* p)              { return __hip_atomic_load(p, __ATOMIC_RELAXED, __HIP_MEMORY_SCOPE_AGENT); }
__device__ __forceinline__ unsigned xb_add(unsigned* p, unsigned v) { return __hip_atomic_fetch_add(p, v, __ATOMIC_RELAXED, __HIP_MEMORY_SCOPE_AGENT); }
__device__ __forceinline__ unsigned xb_xcc_id() { return (unsigned)__builtin_amdgcn_s_getreg((3 << 11) | 20) & 0xFu; }
#define XB_SPIN(cond, bar) do { unsigned _sp = 0; while (cond) { __builtin_amdgcn_s_sleep(1); \
    if ((++_sp & 255u) == 0u) { if (xb_ld(&(bar)[XB_TMO])) break; if (_sp > XB_SPIN_CAP) { atomicAdd(&(bar)[XB_TMO], 1u); break; } } } } while (0)

struct XcdBarrier {
    unsigned* bar; unsigned x;
    volatile LAS unsigned* st;
};

__device__ __forceinline__ XcdBarrier xcd_barrier_post(unsigned* bar, volatile LAS unsigned* st) {
    XcdBarrier b; b.bar = bar; b.x = xb_xcc_id(); b.st = st;
    if (threadIdx.x == 0) (void)xb_add(&bar[XB_XCNT(b.x)], 1u);
    return b;
}
__device__ __forceinline__ void xcd_barrier_complete(unsigned* bar, unsigned x, unsigned& nloc, unsigned& nx) {
    const unsigned G = gridDim.x * gridDim.y * gridDim.z;
    unsigned sum, cnt, mine, sp = 0u;
    for (;;) {
        sum = 0u; cnt = 0u; mine = 0u;
#pragma unroll
        for (unsigned j = 0; j < 16; ++j) { const unsigned c = xb_ld(&bar[XB_XCNT(j)]); sum += c; cnt += (c > 0u) ? 1u : 0u; mine = (j == x) ? c : mine; }
        if (sum == G) break;
        __builtin_amdgcn_s_sleep(1);
        if ((++sp & 255u) == 0u) { if (xb_ld(&bar[XB_TMO])) break; if (sp > XB_SPIN_CAP) { atomicAdd(&bar[XB_TMO], 1u); break; } }
    }
    nloc = mine > 0u ? mine : 1u; nx = cnt > 0u ? cnt : 1u;
}

__device__ __forceinline__ void xcd_barrier(const XcdBarrier& b) {
    asm volatile("s_waitcnt vmcnt(0)" ::: "memory");
    __syncthreads();
    if (threadIdx.x == 0) {
        unsigned* bar = b.bar;
        __builtin_amdgcn_s_waitcnt(0);
        unsigned nloc = b.st[0], nx = b.st[1];
        if (nloc == 0u) { xcd_barrier_complete(bar, b.x, nloc, nx); b.st[0] = nloc; b.st[1] = nx; }
        const unsigned old = xb_add(&bar[XB_XSUB(b.x)], 1u);
        const unsigned gen = old / nloc;
        if (old + 1u == (gen + 1u) * nloc) {
            __builtin_amdgcn_fence(__ATOMIC_RELEASE, "agent");
            asm volatile("s_waitcnt vmcnt(0)" ::: "memory");
            const unsigned og = xb_add(&bar[XB_TOP], 1u);
            const unsigned tg = og / nx;
            if (og + 1u == (tg + 1u) * nx) xb_add(&bar[XB_TOPGEN], 1u);
            else XB_SPIN(xb_ld(&bar[XB_TOPGEN]) == tg, bar);
            __builtin_amdgcn_fence(__ATOMIC_ACQUIRE, "agent");
            xb_add(&bar[XB_XGEN(b.x)], 1u);
            asm volatile("s_waitcnt vmcnt(0)" ::: "memory");
        } else {
            XB_SPIN(xb_ld(&bar[XB_XGEN(b.x)]) == gen, bar);
            __builtin_amdgcn_fence(__ATOMIC_ACQUIRE, "agent");
            asm volatile("s_waitcnt vmcnt(0)" ::: "memory");
        }
    }
    __syncthreads();
}

#ifndef REP_SYNC
#define REP_SYNC 1
#endif
#define GSYNC() do { for (int rs_ = 0; rs_ < REP_SYNC; ++rs_) xcd_barrier(xbar); } while (0)
#ifndef REP_P0
#define REP_P0 1
#endif
#ifndef REP_R0
#define REP_R0 1
#endif
#ifndef REP_G1
#define REP_G1 1
#endif
#ifndef REP_G2
#define REP_G2 1
#endif
#ifndef REP_LIGHT
#define REP_LIGHT 1
#endif
#ifndef REP_ATT
#define REP_ATT 1
#endif
#ifndef REP_GEMM
#define REP_GEMM 1
#endif
#define GEMM_PHASE(EPI, Aptr, Bptr, Mv, Nv, Kv, Eobj) for (int rep_ = 0; rep_ < REP_GEMM; ++rep_) do { int k_ = (Kv); asm volatile("" : "+s"(k_)); pg8::Gemm g_{(const pg8::bf16_t*)(Aptr), (const pg8::bf16_t*)(Bptr), (Mv), (Nv), k_}; pg8::StaticOrder S_; S_.init((Mv), (Nv), (int)gridDim.x, (int)blockIdx.x); \
        pg8::gemm_phase<EPI, pg8::StaticOrder, true, true>(lds, g_, S_, (Eobj)); } while (0)


__device__ __forceinline__ unsigned char* opq_ws(unsigned char* p) { asm volatile("" : "+s"(p)); return p; }
#define WSP(T, off) ((T*)(opq_ws(P.ws) + (off)))
#define W_ WSP(bf16_t, WS_W)
#define CS_ WSP(float, WS_CS)
#define SSQ_ WSP(float, WS_SS)
#define SSKV_ WSP(float, WS_SS + SS_STRIDE)
#define SSA_ WSP(float, WS_SS + 2 * SS_STRIDE)
#define SSF_ WSP(float, WS_SS + 3 * SS_STRIDE)
#define SSF2_ WSP(float, WS_SS + 4 * SS_STRIDE)
#define H_ WSP(bf16_t, WS_H)
#define CQ_ WSP(bf16_t, R_CQ)
#define CKV_ WSP(bf16_t, R_CKV)
#define U_ WSP(bf16_t, R_U)
#define VNT_ WSP(bf16_t, R_VNT)
#define Y_ WSP(bf16_t, R_Y)
#define GB_ WSP(bf16_t, R_GB)
#define QF_ WSP(bf16_t, R_QF)
#define KF_ WSP(bf16_t, R_KF)
#define VT_ WSP(bf16_t, R_VT)
#define MIX_ WSP(bf16_t, R_MIX)
#define F_ WSP(bf16_t, R_F)
#define HMID_ WSP(bf16_t, R_HMID)
#define F2_ WSP(bf16_t, R_F2)
__global__ void __launch_bounds__(NTHR, 2) fwd_kernel(Params P) {
    extern __shared__ __attribute__((aligned(16))) unsigned char lds_raw[];
    LAS unsigned char* lds = (LAS unsigned char*)lds_raw;
    cg::grid_group grid = cg::this_grid();
    volatile LAS unsigned* xst = (volatile LAS unsigned*)(lds + 131072 + 128);
    if (threadIdx.x < 2) xst[threadIdx.x] = 0u;
    __syncthreads();
    const XcdBarrier xbar = xcd_barrier_post((unsigned*)(P.ws + WS_CTL), xst);
#ifndef PHMASK
#define PHMASK 0xFFFF
#endif
    if (PHMASK & 1) for (int rp_ = 0; rp_ < REP_P0; ++rp_) p0_prologue(P, lds);
    grid.sync();
#pragma unroll 1
    for (int l = 0; l < DEPTH; ++l) {
        const size_t wl = (size_t)l * WE_LAYER;
        for (int r1_ = 0; r1_ < REP_G1; ++r1_)
        if (PHMASK & 2) { EpiA E{opq_ws(P.ws), P.sg_ln_g + l * 256, P.sg_ln_b + l * 256};
          GEMM_PHASE(EpiA, H_, W_ + wl + WE_IN, TT, INP, DM, E); }
        GSYNC();
        for (int r2_ = 0; r2_ < REP_G2; ++r2_) {
        if (PHMASK & 4) { EpiQ E{QF_, SSQ_, CS_}; GEMM_PHASE(EpiQ, CQ_, W_ + wl + WE_UQ, TT, 768, QR, E); }
        if (PHMASK & 8) { EpiKV E{KF_, VT_, SSKV_}; GEMM_PHASE(EpiKV, CKV_, W_ + wl + WE_UKV, TT, 1024, KVR, E); }
        }
        GSYNC();
        if (PHMASK & 16) for (int rep_ = 0; rep_ < REP_ATT; ++rep_) attn_phase(lds, QF_, KF_, VT_, MIX_, SSA_);
        GSYNC();
        for (int rl_ = 0; rl_ < REP_LIGHT; ++rl_) if (PHMASK & 32) light_phase(lds, VNT_, W_ + wl + WE_WC, P.b_sp + l * 512, U_, Y_, GB_, P.conv_w + l * 768, SSA_, MIX_);
        GSYNC();
        if (PHMASK & 64) { EpiF<true> E{F_, SSF_, SSA_}; GEMM_PHASE(EpiF<true>, MIX_, W_ + wl + WE_OUT, TT, DM, DM, E); }
        GSYNC();
        if (PHMASK & 128) resid_phase(H_, F_, SSF_, P.mix_post_g + l * DM, WSP(float, WS_RS), nullptr);
        GSYNC();
        if (PHMASK & 256) { EpiGU E{HMID_, WSP(float, WS_RS)}; GEMM_PHASE(EpiGU, H_, W_ + wl + WE_GU, TT, 2 * DFF, DM, E); }
        GSYNC();
        if (PHMASK & 512) { EpiF<false> E{F2_, SSF2_, nullptr}; GEMM_PHASE(EpiF<false>, HMID_, W_ + wl + WE_DN, TT, DM, DFF, E); }
        GSYNC();
        if (PHMASK & 1024) resid_phase(H_, F2_, SSF2_, P.ffn_post_g + l * DM, WSP(float, WS_RS), l + 1 < DEPTH ? nullptr : P.out);
        if (l + 1 < DEPTH) GSYNC();
    }
}

extern "C" void kernel_launch(void* const* d_in, const int* in_sizes, int n_in, void* d_out, int out_size, void* d_ws, size_t ws_size, hipStream_t stream) {
    static int grid = 0;
    if (grid == 0) {
        if (n_in != 21 || out_size != TT * DM || ws_size < WS_END) { fprintf(stderr, "kernel_launch: unexpected problem (n_in %d out %d ws %zu)\n", n_in, out_size, ws_size); grid = -1; return; }
        int dev = 0, cus = 0, per_cu = 0;
        hipGetDevice(&dev); hipDeviceGetAttribute(&cus, hipDeviceAttributeMultiprocessorCount, dev);
        if (hipFuncSetAttribute((const void*)fwd_kernel, hipFuncAttributeMaxDynamicSharedMemorySize, LDS_BYTES) != hipSuccess) { fprintf(stderr, "kernel_launch: hipFuncSetAttribute failed\n"); grid = -1; return; }
        if (hipOccupancyMaxActiveBlocksPerMultiprocessor(&per_cu, (const void*)fwd_kernel, NTHR, LDS_BYTES) != hipSuccess || per_cu < 1) { fprintf(stderr, "kernel_launch: occupancy query gave %d\n", per_cu); per_cu = 1; }
        (void)hipGetLastError();
        grid = cus;
    }
    if (grid < 0) return;
    Params p{};
    p.x = (const float*)d_in[0]; p.pos = (const int*)d_in[1];
    p.mix_pre_g = (const float*)d_in[2]; p.mix_post_g = (const float*)d_in[3]; p.ffn_pre_g = (const float*)d_in[4]; p.ffn_post_g = (const float*)d_in[5];
    p.w_in = (const float*)d_in[6]; p.q_norm_g = (const float*)d_in[7]; p.w_uq = (const float*)d_in[8]; p.kv_norm_g = (const float*)d_in[9]; p.w_ukv = (const float*)d_in[10];
    p.sg_ln_g = (const float*)d_in[11]; p.sg_ln_b = (const float*)d_in[12]; p.w_sp = (const float*)d_in[13]; p.b_sp = (const float*)d_in[14]; p.conv_w = (const float*)d_in[15];
    p.out_norm_g = (const float*)d_in[16]; p.w_out = (const float*)d_in[17]; p.w_gate = (const float*)d_in[18]; p.w_up = (const float*)d_in[19]; p.w_down = (const float*)d_in[20];
    p.out = (float*)d_out; p.ws = (unsigned char*)d_ws;
    for (int i = 0; i < 16; ++i) p.inv_rev[i] = pow(10000.0, -(double)i / 16.0) / 6.283185307179586476925;
    if (hipMemsetAsync((char*)d_ws + WS_CTL, 0, CTL_BYTES, stream) != hipSuccess) { fprintf(stderr, "kernel_launch: memset failed\n"); return; }
    void* args[] = {&p};
    hipError_t e = hipLaunchCooperativeKernel((const void*)fwd_kernel, dim3(grid), dim3(NTHR), args, LDS_BYTES, stream);
    if (e != hipSuccess) fprintf(stderr, "kernel_launch: cooperative launch failed: %s (grid %d)\n", hipGetErrorString(e), grid);
}
```

```cpp
#include <hip/hip_runtime.h>
#include <hip/hip_cooperative_groups.h>
#include <cstdio>
#include <cstdint>
#include <cmath>
namespace cg = cooperative_groups;
namespace pg8 {
#define PG8_LAS __attribute__((address_space(3)))
typedef unsigned short bf16_t;
typedef short bf16x8 __attribute__((ext_vector_type(8)));
typedef float f32x4 __attribute__((ext_vector_type(4)));
typedef unsigned u32x4 __attribute__((ext_vector_type(4)));
constexpr int BM = 256, BK = 64, HALF = 128, HTB = HALF * BK * 2  , STAGE_BYTES = 8 * HTB, NXCD = 8, WGM = 8;

__host__ __device__ __forceinline__ int lds_byte(int r, int c) { const int st = (r >> 4) * 2 + (c >> 5), rr = r & 15, cc = c & 31, ob = rr * 64 + cc * 2; return st * 1024 + (ob ^ (((ob >> 9) & 1) << 5)); }
__host__ __device__ __forceinline__ void stage_rc(int b, int& R, int& C) { const int st = b / 1024, sb = b % 1024, swz = sb ^ (((sb >> 9) & 1) << 5); R = (st >> 1) * 16 + swz / 64; C = (st & 1) * 32 + (swz % 64) / 2; }
__host__ __device__ __forceinline__ int perm32(int rho) { const int n = rho >> 4, i = rho & 15; return 8 * (i >> 2) + 4 * n + (i & 3); }

struct Unit { int pm, pn; };
struct Gemm { const bf16_t* A; const bf16_t* Bt; int M, N, K; };

struct StaticOrder {
    int nM, nN, nwg, G, c;
    __host__ __device__ void init(int M, int N, int G_, int c_) { nM = M / BM; nN = N / BM; nwg = nM * nN; G = G_; c = c_; }
    __host__ __device__ bool next(int i, Unit& u) const {
        const long L = (long)i * G + c; if (L >= nwg) return false;
        int wgid = (int)L; { const int q = nwg / NXCD, r = nwg % NXCD, xcd = wgid % NXCD, off = wgid / NXCD; wgid = (xcd < r ? xcd * (q + 1) : r * (q + 1) + (xcd - r) * q) + off; }
        const int nig = WGM * nN, gid = wgid / nig, fm = gid * WGM, gsz = (nM - fm) < WGM ? (nM - fm) : WGM;
        u.pm = fm + ((wgid % nig) % gsz); u.pn = (wgid % nig) / gsz; return true;
    }
    __device__ __forceinline__ void a_ready(const Unit&) const {}
    __device__ __forceinline__ void done(const Unit&) const {}
};

template <class Epi, class Sched, bool ALIGN_EPI = false, bool SP2 = false>
__device__ __forceinline__ void gemm_phase(PG8_LAS unsigned char* lds, const Gemm g, const Sched& S, const Epi& E) {
    int tid_ = threadIdx.x; asm volatile("" : "+v"(tid_));
    const int tid = tid_, wid = __builtin_amdgcn_readfirstlane(tid >> 6), lane = tid & 63, wr = wid >> 2, wc = wid & 3, fr = lane & 15, fq = lane >> 4;
    const int K = g.K, nt = K / BK;
    unsigned voffA[2], voffB[2];
#pragma unroll
    for (int i = 0; i < 2; ++i) { int R, C; stage_rc(tid * 16 + i * 8192, R, C); const int Rb = Epi::PERM ? ((R & ~31) + perm32(R & 31)) : R;
        voffA[i] = (unsigned)(R * K + C) * 2u; voffB[i] = (unsigned)(Rb * K + C) * 2u; }
    const size_t kstep = (size_t)(BK * 2);
    const size_t hstep = (size_t)HALF * K * 2;
    const size_t tstep = 2 * hstep;
    const unsigned ldsw = (unsigned)wid * 1024u;
    const int aoff = lds_byte(wr * 64 + fr, fq * 8), boff = lds_byte(wc * 32 + fr, fq * 8);
#define PG8_SA(b, h) (((b) * 2 + (h)) * HTB)
#define PG8_SB(b, h) ((4 + (b) * 2 + (h)) * HTB)
#define PG8_STAGE(bufoff, gbase, voff) do { _Pragma("unroll") for (int _i = 0; _i < 2; ++_i) \
        __builtin_amdgcn_global_load_lds((const unsigned*)((const char*)(gbase) + (voff)[_i]), (PG8_LAS unsigned*)(lds + (bufoff) + ldsw + _i * 8192), 16, 0, 0); } while (0)
#define PG8_LDA(dst, b, h) do { _Pragma("unroll") for (int m = 0; m < 4; ++m) _Pragma("unroll") for (int k = 0; k < 2; ++k) dst[m][k] = *(const PG8_LAS bf16x8*)(lds + PG8_SA(b, h) + aoff + m * 2048 + k * 1024); } while (0)
#define PG8_LDB(dst, b, h) do { _Pragma("unroll") for (int n = 0; n < 2; ++n) _Pragma("unroll") for (int k = 0; k < 2; ++k) dst[n][k] = *(const PG8_LAS bf16x8*)(lds + PG8_SB(b, h) + boff + n * 2048 + k * 1024); } while (0)
#define PG8_MMA(ai, bj, At, Bt) do { __builtin_amdgcn_s_setprio(1); _Pragma("unroll") for (int m = 0; m < 4; ++m) _Pragma("unroll") for (int n = 0; n < 2; ++n) _Pragma("unroll") for (int k = 0; k < 2; ++k) \
        acc[ai][bj][m][n] = __builtin_amdgcn_mfma_f32_16x16x32_bf16(Bt[n][k], At[m][k], acc[ai][bj][m][n], 0, 0, 0); __builtin_amdgcn_s_setprio(0); } while (0)
#define PG8_WAIT_V(n) asm volatile("s_waitcnt vmcnt(" #n ")" ::: "memory")
#define PG8_WAIT_L(n) asm volatile("s_waitcnt lgkmcnt(" #n ")" ::: "memory")
#define PG8_BAR __builtin_amdgcn_s_barrier()
#define PG8_SCHED __builtin_amdgcn_sched_barrier(0)
    Unit cur, nxt; int ui = 0;
    if (!S.next(0, cur)) return;
    f32x4 acc[2][2][4][2];
#pragma unroll
    for (int a = 0; a < 2; ++a)
#pragma unroll
        for (int b = 0; b < 2; ++b)
#pragma unroll
            for (int m = 0; m < 4; ++m)
#pragma unroll
                for (int n = 0; n < 2; ++n) acc[a][b][m][n] = (f32x4){0.f, 0.f, 0.f, 0.f};
    bf16x8 At[4][2], B0[2][2], B1[2][2];
    const char* cA = (const char*)g.A + (size_t)cur.pm * tstep; const char* cB = (const char*)g.Bt + (size_t)cur.pn * tstep;
    S.a_ready(cur);
    if constexpr (SP2) {
        PG8_STAGE(PG8_SB(0, 0), cB, voffB); PG8_STAGE(PG8_SB(0, 1), cB + hstep, voffB); PG8_STAGE(PG8_SA(0, 0), cA, voffA); PG8_STAGE(PG8_SA(0, 1), cA + hstep, voffA);
        if (wr == 1) PG8_BAR;
        PG8_WAIT_V(2); PG8_BAR;
        PG8_STAGE(PG8_SB(1, 0), cB + kstep, voffB); PG8_STAGE(PG8_SA(1, 0), cA + kstep, voffA); PG8_STAGE(PG8_SB(1, 1), cB + hstep + kstep, voffB);
        PG8_WAIT_V(6); PG8_BAR;
    } else {
        PG8_STAGE(PG8_SB(0, 0), cB, voffB); PG8_STAGE(PG8_SA(0, 0), cA, voffA); PG8_STAGE(PG8_SB(0, 1), cB + hstep, voffB); PG8_STAGE(PG8_SA(0, 1), cA + hstep, voffA);
        if (wr == 1) PG8_BAR;
        PG8_WAIT_V(4); PG8_BAR;
        PG8_STAGE(PG8_SB(1, 0), cB + kstep, voffB); PG8_STAGE(PG8_SA(1, 0), cA + kstep, voffA); PG8_STAGE(PG8_SB(1, 1), cB + hstep + kstep, voffB);
        PG8_WAIT_V(6); PG8_BAR;
    }
    for (;;) {
        const bool has_next = S.next(ui + 1, nxt);
        const char* nA = has_next ? (const char*)g.A + (size_t)nxt.pm * tstep : cA; const char* nB = has_next ? (const char*)g.Bt + (size_t)nxt.pn * tstep : cB;
        for (int t = 0; t < nt; t += 2) {
            const bool last = (t == nt - 2);
            const char* a1 = cA + (size_t)(t + 1) * kstep;
            const char* a2 = last ? nA : cA + (size_t)(t + 2) * kstep; const char* b2 = last ? nB : cB + (size_t)(t + 2) * kstep;
            const char* a3 = a2 + kstep; const char* b3 = b2 + kstep;
            if (last && has_next) S.a_ready(nxt);
            if constexpr (SP2) {
            PG8_LDB(B0, 0, 0); PG8_LDB(B1, 0, 1); PG8_SCHED; PG8_LDA(At, 0, 0); PG8_STAGE(PG8_SA(1, 1), a1 + hstep, voffA);
            PG8_WAIT_V(8); PG8_WAIT_L(0); PG8_BAR; PG8_MMA(0, 0, At, B0); PG8_MMA(0, 1, At, B1); PG8_BAR; PG8_SCHED;
            PG8_LDA(At, 0, 1); PG8_STAGE(PG8_SB(0, 0), b2, voffB); PG8_STAGE(PG8_SB(0, 1), b2 + hstep, voffB); PG8_STAGE(PG8_SA(0, 0), a2, voffA);
            PG8_WAIT_V(8); PG8_WAIT_L(0); PG8_BAR; PG8_MMA(1, 0, At, B0); PG8_MMA(1, 1, At, B1); PG8_BAR; PG8_SCHED;
            PG8_LDB(B0, 1, 0); PG8_LDB(B1, 1, 1); PG8_SCHED; PG8_LDA(At, 1, 0); PG8_STAGE(PG8_SA(0, 1), a2 + hstep, voffA);
            PG8_WAIT_V(8); PG8_WAIT_L(0); PG8_BAR; PG8_MMA(0, 0, At, B0); PG8_MMA(0, 1, At, B1); PG8_BAR; PG8_SCHED;
            PG8_LDA(At, 1, 1); PG8_STAGE(PG8_SB(1, 0), b3, voffB); PG8_STAGE(PG8_SB(1, 1), b3 + hstep, voffB); PG8_STAGE(PG8_SA(1, 0), a3, voffA);
            PG8_WAIT_V(8); PG8_WAIT_L(0); PG8_BAR; PG8_MMA(1, 0, At, B0); PG8_MMA(1, 1, At, B1); PG8_BAR; PG8_SCHED;
            } else {
            PG8_LDB(B0, 0, 0); PG8_SCHED; PG8_LDA(At, 0, 0); PG8_STAGE(PG8_SA(1, 1), a1 + hstep, voffA);
            PG8_WAIT_L(8); PG8_BAR; PG8_WAIT_L(0); PG8_MMA(0, 0, At, B0); PG8_BAR; PG8_SCHED;
            PG8_LDB(B1, 0, 1); PG8_STAGE(PG8_SB(0, 0), b2, voffB);
            PG8_BAR; PG8_WAIT_L(0); PG8_MMA(0, 1, At, B1); PG8_BAR;
            PG8_LDA(At, 0, 1); PG8_STAGE(PG8_SA(0, 0), a2, voffA);
            PG8_BAR; PG8_WAIT_L(0); PG8_MMA(1, 0, At, B0); PG8_BAR; PG8_SCHED;
            PG8_STAGE(PG8_SB(0, 1), b2 + hstep, voffB);
            PG8_WAIT_V(6); PG8_BAR; PG8_MMA(1, 1, At, B1); PG8_BAR;
            PG8_LDB(B0, 1, 0); PG8_SCHED; PG8_LDA(At, 1, 0); PG8_STAGE(PG8_SA(0, 1), a2 + hstep, voffA);
            PG8_WAIT_L(8); PG8_BAR; PG8_WAIT_L(0); PG8_MMA(0, 0, At, B0); PG8_BAR; PG8_SCHED;
            PG8_LDB(B1, 1, 1); PG8_STAGE(PG8_SB(1, 0), b3, voffB);
            PG8_BAR; PG8_WAIT_L(0); PG8_MMA(0, 1, At, B1); PG8_BAR;
            PG8_LDA(At, 1, 1); PG8_STAGE(PG8_SA(1, 0), a3, voffA);
            PG8_BAR; PG8_WAIT_L(0); PG8_MMA(1, 0, At, B0); PG8_BAR; PG8_SCHED;
            PG8_STAGE(PG8_SB(1, 1), b3 + hstep, voffB);
            PG8_WAIT_V(6); PG8_BAR; PG8_MMA(1, 1, At, B1); PG8_BAR;
            }
        }
        if constexpr (ALIGN_EPI) { if (wr == 0) PG8_BAR; }
        if constexpr (!Epi::AFTER_DRAIN) { E(acc, cur, wr, wc, fr, fq); S.done(cur); }
        if (!has_next) break;
#pragma unroll
        for (int a = 0; a < 2; ++a)
#pragma unroll
            for (int b = 0; b < 2; ++b)
#pragma unroll
                for (int m = 0; m < 4; ++m)
#pragma unroll
                    for (int n = 0; n < 2; ++n) acc[a][b][m][n] = (f32x4){0.f, 0.f, 0.f, 0.f};
        cur = nxt; cA = nA; cB = nB; ++ui;
        if constexpr (ALIGN_EPI) { if (wr == 1) PG8_BAR; }
    }
    PG8_WAIT_V(0);
    if constexpr (!ALIGN_EPI) { if (wr == 0) PG8_BAR; }
    PG8_BAR;
    if constexpr (Epi::AFTER_DRAIN) { E.fused(acc, cur, wr, wc, fr, fq, lds, wid, lane); S.done(cur); }
#undef PG8_SA
#undef PG8_SB
#undef PG8_STAGE
#undef PG8_LDA
#undef PG8_LDB
#undef PG8_MMA
#undef PG8_WAIT_V
#undef PG8_WAIT_L
#undef PG8_BAR
#undef PG8_SCHED
}
}

#define LAS __attribute__((address_space(3)))
typedef unsigned short bf16_t;
typedef short bf16x8 __attribute__((ext_vector_type(8)));
typedef float f32x4 __attribute__((ext_vector_type(4)));
typedef float f32x16 __attribute__((ext_vector_type(16)));
typedef unsigned u32x2 __attribute__((ext_vector_type(2)));
typedef unsigned u32x4 __attribute__((ext_vector_type(4)));

constexpr int DM = 1024, NB = 8, SEQ = 4096, TT = NB * SEQ, DEPTH = 4, NH = 8;
constexpr int QR = 384, KVR = 256, DFF = 2816, INW = 1952, INP = 2048;
constexpr float EPS = 1e-6f;
constexpr float QSCALE = 0.10206207261596575f * 1.4426950408889634f;
constexpr int NWAVES = 8, NTHR = 512;

constexpr size_t MiB = 1u << 20;
constexpr size_t WE_IN = 0, WE_UQ = WE_IN + (size_t)INP * DM, WE_UKV = WE_UQ + (size_t)768 * QR, WE_OUT = WE_UKV + (size_t)1024 * KVR,
                 WE_GU = WE_OUT + (size_t)DM * DM, WE_DN = WE_GU + (size_t)2 * DFF * DM, WE_WC = WE_DN + (size_t)DM * DFF, WE_LAYER = WE_WC + (size_t)4 * 128 * 128;
static_assert(WE_LAYER * 2 * DEPTH <= 96 * MiB, "weights region");
constexpr size_t WS_W = 0, WS_CS = 96 * MiB, WS_SS = 100 * MiB, WS_H = 112 * MiB, WS_R2 = 176 * MiB;
constexpr size_t WS_CTL = 110 * MiB, CTL_BYTES = 16384;
constexpr size_t WS_RS = 111 * MiB;
constexpr size_t SS_STRIDE = 2 * MiB;
constexpr size_t R_CQ = WS_R2, R_CKV = WS_R2 + 24 * MiB, R_U = WS_R2 + 40 * MiB, R_VNT = WS_R2 + 56 * MiB, R_Y = WS_R2 + 72 * MiB, R_GB = WS_R2 + 88 * MiB,
                 R_QF = WS_R2 + 104 * MiB, R_KF = WS_R2 + 152 * MiB, R_VT = WS_R2 + 200 * MiB, R_MIX = WS_R2 + 232 * MiB, WS_END = WS_R2 + 296 * MiB;
constexpr size_t R_F = R_QF, R_HMID = WS_R2, R_F2 = WS_R2 + 176 * MiB;

constexpr int LDS_BYTES = 132 * 1024;

struct Params {
    const float* x; const int* pos;
    const float *mix_pre_g, *mix_post_g, *ffn_pre_g, *ffn_post_g, *w_in, *q_norm_g, *w_uq, *kv_norm_g, *w_ukv, *sg_ln_g, *sg_ln_b, *w_sp, *b_sp, *conv_w,
                *out_norm_g, *w_out, *w_gate, *w_up, *w_down;
    float* out; unsigned char* ws;
    double inv_rev[16];
};

__device__ __forceinline__ unsigned pkbf(float lo, float hi) {
    typedef float f2_t __attribute__((ext_vector_type(2))); typedef __bf16 b2_t __attribute__((ext_vector_type(2)));
    f2_t v = {lo, hi}; b2_t b = __builtin_convertvector(v, b2_t); return __builtin_bit_cast(unsigned, b);
}
__device__ __forceinline__ bf16_t f2bf(float f) { return (bf16_t)(pkbf(f, 0.f) & 0xffffu); }
__device__ __forceinline__ float bflo(unsigned w) { return __uint_as_float(w << 16); }
__device__ __forceinline__ float bfhi(unsigned w) { return __uint_as_float(w & 0xffff0000u); }
__device__ __forceinline__ void store4(bf16_t* p, f32x4 v) { u32x2 w; w.x = pkbf(v[0], v[1]); w.y = pkbf(v[2], v[3]); *(u32x2*)p = w; }
__device__ __forceinline__ f32x4 load4bf(const bf16_t* p) { const u32x2 w = *(const u32x2*)p; return (f32x4){bflo(w.x), bfhi(w.x), bflo(w.y), bfhi(w.y)}; }
__device__ __forceinline__ float wave_sum(float v) {
#pragma unroll
    for (int o = 1; o < 64; o <<= 1) v += __shfl_xor(v, o);
    return v;
}
__device__ __forceinline__ float gelu_tanh(float x) {
    const float u = 0.7978845608028654f * (x + 0.044715f * x * x * x);
    return x * __builtin_amdgcn_rcpf(1.f + __builtin_amdgcn_exp2f(-2.f * 1.4426950408889634f * u));
}
__device__ __forceinline__ float silu_f(float x) { return x * __builtin_amdgcn_rcpf(1.f + __builtin_amdgcn_exp2f(-1.4426950408889634f * x)); }
__device__ __forceinline__ float dot4(f32x4 v) { return (v[0] * v[0] + v[1] * v[1]) + (v[2] * v[2] + v[3] * v[3]); }
__device__ __forceinline__ float sum4(f32x4 v) { return (v[0] + v[1]) + (v[2] + v[3]); }
__device__ __forceinline__ int crow(int r, int hi) { return (r & 3) + 8 * (r >> 2) + 4 * hi; }
__device__ __forceinline__ int opq(int v) { asm volatile("" : "+v"(v)); return v; }
#define TID_OPQ() opq((int)threadIdx.x)

typedef pg8::f32x4 pf4;
#define ACC_T const pf4 (&acc)[2][2][4][2]

struct EpiA {
    static constexpr bool PERM = false, AFTER_DRAIN = false;
    unsigned char* ws; const float *lng, *lnb;
    __device__ __forceinline__ void operator()(ACC_T, const pg8::Unit& u, int wr, int wc, int fr_, int fq_) const {
        const int fr = opq(fr_), fq = opq(fq_);
        bf16_t *CQ = (bf16_t*)(ws + R_CQ), *CKV = (bf16_t*)(ws + R_CKV), *U = (bf16_t*)(ws + R_U), *VNT = (bf16_t*)(ws + R_VNT), *Y = (bf16_t*)(ws + R_Y), *GB = (bf16_t*)(ws + R_GB), *Kf = (bf16_t*)(ws + R_KF);
        float *SSQ = (float*)(ws + WS_SS), *SSKV = (float*)(ws + WS_SS + SS_STRIDE); const float* CS = (const float*)(ws + WS_CS); const float* RS = (const float*)(ws + WS_RS);
        const int rbase = u.pm * 256 + wr * 64 + fr, cl = wc * 32 + 4 * fq;
        if (u.pn == 0 || u.pn == 2) {
            bf16_t* O = u.pn == 0 ? CQ : CKV; const int ld = u.pn == 0 ? QR : KVR; float* SS = u.pn == 0 ? SSQ : SSKV;
#pragma unroll
            for (int ai = 0; ai < 2; ++ai)
#pragma unroll
                for (int m = 0; m < 4; ++m) { const int row = rbase + 128 * ai + 16 * m; float s = 0.f; const float rx = RS[row];
#pragma unroll
                    for (int bj = 0; bj < 2; ++bj)
#pragma unroll
                        for (int n = 0; n < 2; ++n) { const f32x4 v = acc[ai][bj][m][n] * rx; s += dot4(v); store4(O + (size_t)row * ld + 128 * bj + cl + 16 * n, v); }
                    s += __shfl_xor(s, 16); s += __shfl_xor(s, 32);
                    if (fq == 0) SS[(size_t)row * 16 + wc] = s; asm volatile("" ::: "memory"); }
        } else if (u.pn == 1) {
#pragma unroll
            for (int ai = 0; ai < 2; ++ai)
#pragma unroll
                for (int m = 0; m < 4; ++m) { const int row = rbase + 128 * ai + 16 * m; float s = 0.f; const float rx = RS[row];
#pragma unroll
                    for (int n = 0; n < 2; ++n) { const f32x4 v = acc[ai][0][m][n] * rx; s += dot4(v); store4(CQ + (size_t)row * QR + 256 + cl + 16 * n, v); }
                    s += __shfl_xor(s, 16); s += __shfl_xor(s, 32);
                    if (fq == 0) SSQ[(size_t)row * 16 + 4 + wc] = s;
                    if (wc == 0) {
                        const f32x4 t1 = acc[ai][1][m][0] * rx, t2 = acc[ai][1][m][1] * rx;
                        const f32x4 c4 = *(const f32x4*)(CS + (size_t)row * 32 + 4 * fq), s4 = *(const f32x4*)(CS + (size_t)row * 32 + 16 + 4 * fq);
                        const f32x4 o1 = t1 * c4 - t2 * s4, o2 = t2 * c4 + t1 * s4;
                        const int b = row >> 12, sp = row & 4095;
#pragma unroll
                        for (int hd = 0; hd < NH; ++hd) { bf16_t* kp = Kf + ((size_t)(b * NH + hd) * SEQ + sp) * 96 + 64 + 4 * fq; store4(kp, o1); store4(kp + 16, o2); }
                    } asm volatile("" ::: "memory"); }
        } else if (u.pn == 3 || u.pn == 7) {
            bf16_t* O = u.pn == 3 ? U : GB; const bool act = (u.pn == 3);
#pragma unroll
            for (int ai = 0; ai < 2; ++ai)
#pragma unroll
                for (int m = 0; m < 4; ++m) { const int row = rbase + 128 * ai + 16 * m; const float rx = RS[row];
#pragma unroll
                    for (int bj = 0; bj < 2; ++bj)
#pragma unroll
                        for (int n = 0; n < 2; ++n) { f32x4 v = acc[ai][bj][m][n] * rx;
                            if (act) { v[0] = gelu_tanh(v[0]); v[1] = gelu_tanh(v[1]); v[2] = gelu_tanh(v[2]); v[3] = gelu_tanh(v[3]); }
                            store4(O + (size_t)row * 256 + 128 * bj + cl + 16 * n, v); } asm volatile("" ::: "memory"); }
        } else if (u.pn == 4) {
#pragma unroll
            for (int ai = 0; ai < 2; ++ai)
#pragma unroll
                for (int m = 0; m < 4; ++m) { const int row = rbase + 128 * ai + 16 * m; f32x4 g[2][2]; float s = 0.f; const float rx = RS[row];
#pragma unroll
                    for (int bj = 0; bj < 2; ++bj)
#pragma unroll
                        for (int n = 0; n < 2; ++n) { f32x4 v = acc[ai][bj][m][n] * rx; v[0] = gelu_tanh(v[0]); v[1] = gelu_tanh(v[1]); v[2] = gelu_tanh(v[2]); v[3] = gelu_tanh(v[3]); g[bj][n] = v; s += sum4(v); }
                    s += __shfl_xor(s, 16); s += __shfl_xor(s, 32);
                    const float mu = s * (1.f / 64.f); float q = 0.f;
#pragma unroll
                    for (int bj = 0; bj < 2; ++bj)
#pragma unroll
                        for (int n = 0; n < 2; ++n) { g[bj][n] = g[bj][n] - mu; q += dot4(g[bj][n]); }
                    q += __shfl_xor(q, 16); q += __shfl_xor(q, 32);
                    const float rstd = 1.f / sqrtf(q * (1.f / 64.f) + EPS);
                    bf16_t* vb = VNT + ((size_t)((row >> 7) * 4 + wc) * 64) * 128 + (row & 127);
#pragma unroll
                    for (int bj = 0; bj < 2; ++bj)
#pragma unroll
                        for (int n = 0; n < 2; ++n) { const int e = 32 * bj + 16 * n + 4 * fq; const f32x4 gg = *(const f32x4*)(lng + 64 * wc + e), bb = *(const f32x4*)(lnb + 64 * wc + e);
                            const f32x4 o = g[bj][n] * rstd * gg + bb;
#pragma unroll
                            for (int j = 0; j < 4; ++j) vb[(size_t)(e + j) * 128] = f2bf(o[j]); } asm volatile("" ::: "memory"); }
        } else {
            const int cb = 128 * (u.pn - 5) + cl;
#pragma unroll
            for (int ai = 0; ai < 2; ++ai)
#pragma unroll
                for (int m = 0; m < 4; ++m) { const int row = rbase + 128 * ai + 16 * m; const float rx = RS[row], rx2 = rx * rx;
#pragma unroll
                    for (int n = 0; n < 2; ++n) store4(Y + (size_t)row * 256 + cb + 16 * n, acc[ai][0][m][n] * acc[ai][1][m][n] * rx2); asm volatile("" ::: "memory"); }
        }
    }
};

struct EpiQ {
    static constexpr bool PERM = false, AFTER_DRAIN = false;
    bf16_t* Qf; const float* SSQ; const float* CS;
    __device__ __forceinline__ void operator()(ACC_T, const pg8::Unit& u, int wr, int wc, int fr_, int fq_) const {
        const int fr = opq(fr_), fq = opq(fq_);
        const int rbase = u.pm * 256 + wr * 64 + fr;
#pragma unroll
        for (int ai = 0; ai < 2; ++ai)
#pragma unroll
            for (int m = 0; m < 4; ++m) { const int row = rbase + 128 * ai + 16 * m;
                const f32x4 sa = *(const f32x4*)(SSQ + (size_t)row * 16), sb = *(const f32x4*)(SSQ + (size_t)row * 16 + 4);
                const float rs = QSCALE / sqrtf((sum4(sa) + sum4(sb)) * (1.f / QR) + EPS);
                const int b = row >> 12, sp = row & 4095;
#pragma unroll
                for (int bj = 0; bj < 2; ++bj) { const int p = 8 * u.pn + 4 * bj + wc, head = p / 3, part = p - 3 * head;
                    bf16_t* base = Qf + ((size_t)(b * NH + head) * SEQ + sp) * 96;
                    if (part < 2) {
#pragma unroll
                        for (int n = 0; n < 2; ++n) store4(base + 32 * part + 16 * n + 4 * fq, acc[ai][bj][m][n] * rs);
                    } else {
                        const f32x4 t1 = acc[ai][bj][m][0] * rs, t2 = acc[ai][bj][m][1] * rs;
                        const f32x4 c4 = *(const f32x4*)(CS + (size_t)row * 32 + 4 * fq), s4 = *(const f32x4*)(CS + (size_t)row * 32 + 16 + 4 * fq);
                        store4(base + 64 + 4 * fq, t1 * c4 - t2 * s4); store4(base + 80 + 4 * fq, t2 * c4 + t1 * s4);
                    } } asm volatile("" ::: "memory"); }
    }
};

struct EpiKV {
    static constexpr bool PERM = false, AFTER_DRAIN = false;
    bf16_t *Kf, *Vt; const float* SSKV;
    __device__ __forceinline__ void operator()(ACC_T, const pg8::Unit& u, int wr, int wc, int fr_, int fq_) const {
        const int fr = opq(fr_), fq = opq(fq_);
        const int rbase = u.pm * 256 + wr * 64 + fr;
#pragma unroll
        for (int ai = 0; ai < 2; ++ai)
#pragma unroll
            for (int m = 0; m < 4; ++m) { const int row = rbase + 128 * ai + 16 * m;
                const f32x4 sa = *(const f32x4*)(SSKV + (size_t)row * 16);
                const float rs = 1.f / sqrtf(sum4(sa) * (1.f / KVR) + EPS);
                const int b = row >> 12, sp = row & 4095;
#pragma unroll
                for (int bj = 0; bj < 2; ++bj) { const int p = 8 * u.pn + 4 * bj + wc, head = p >> 2, part = p & 3;
                    if (part < 2) { bf16_t* base = Kf + ((size_t)(b * NH + head) * SEQ + sp) * 96 + 32 * part + 4 * fq;
#pragma unroll
                        for (int n = 0; n < 2; ++n) store4(base + 16 * n, acc[ai][bj][m][n] * rs);
                    } else { bf16_t* base = Vt + ((size_t)(b * NH + head) * 64 + 32 * (part - 2) + 4 * fq) * SEQ + sp;
#pragma unroll
                        for (int n = 0; n < 2; ++n) { const f32x4 v = acc[ai][bj][m][n] * rs;
#pragma unroll
                            for (int j = 0; j < 4; ++j) base[(size_t)(16 * n + j) * SEQ] = f2bf(v[j]); } } } asm volatile("" ::: "memory"); }
    }
};

template <bool ROWSCALE> struct EpiF {
    static constexpr bool PERM = true, AFTER_DRAIN = false;
    bf16_t* F; float* SS; const float* SSA;
    __device__ __forceinline__ void operator()(ACC_T, const pg8::Unit& u, int wr, int wc, int fr_, int fq_) const {
        const int fr = opq(fr_), fq = opq(fq_);
        const int rbase = u.pm * 256 + wr * 64 + fr, cl = u.pn * 256 + wc * 32 + 8 * fq;
#pragma unroll
        for (int ai = 0; ai < 2; ++ai)
#pragma unroll
            for (int m = 0; m < 4; ++m) { const int row = rbase + 128 * ai + 16 * m; float s = 0.f; float ra = 1.f;
                if (ROWSCALE) { const float* sp = SSA + (size_t)row * 16; ra = __builtin_amdgcn_rsqf((sum4(*(const f32x4*)sp) + sum4(*(const f32x4*)(sp + 4))) * (1.f / 512.f) + EPS); }
#pragma unroll
                for (int bj = 0; bj < 2; ++bj) { const f32x4 v0 = acc[ai][bj][m][0] * ra, v1 = acc[ai][bj][m][1] * ra; s += dot4(v0) + dot4(v1);
                    u32x4 w; w.x = pkbf(v0[0], v0[1]); w.y = pkbf(v0[2], v0[3]); w.z = pkbf(v1[0], v1[1]); w.w = pkbf(v1[2], v1[3]);
                    *(u32x4*)(F + (size_t)row * DM + 128 * bj + cl) = w; }
                s += __shfl_xor(s, 16); s += __shfl_xor(s, 32);
                if (fq == 0) SS[(size_t)row * 16 + 4 * u.pn + wc] = s; asm volatile("" ::: "memory"); }
    }
};

struct EpiGU {
    static constexpr bool PERM = true, AFTER_DRAIN = false;
    bf16_t* HM; const float* RS;
    __device__ __forceinline__ void operator()(ACC_T, const pg8::Unit& u, int wr, int wc, int fr_, int fq_) const {
        const int fr = opq(fr_), fq = opq(fq_);
        const int rbase = u.pm * 256 + wr * 64 + fr, cb = u.pn * 128 + wc * 32 + 8 * fq;
#pragma unroll
        for (int ai = 0; ai < 2; ++ai)
#pragma unroll
            for (int m = 0; m < 4; ++m) { const int row = rbase + 128 * ai + 16 * m; const float rx = RS[row]; float o[8];
#pragma unroll
                for (int n = 0; n < 2; ++n) { const f32x4 g = acc[ai][0][m][n] * rx, up = acc[ai][1][m][n] * rx;
#pragma unroll
                    for (int j = 0; j < 4; ++j) o[4 * n + j] = silu_f(g[j]) * up[j]; }
                u32x4 w; w.x = pkbf(o[0], o[1]); w.y = pkbf(o[2], o[3]); w.z = pkbf(o[4], o[5]); w.w = pkbf(o[6], o[7]);
                *(u32x4*)(HM + (size_t)row * DFF + cb) = w; asm volatile("" ::: "memory"); }
    }
};

__device__ __forceinline__ void conv_item(const float* src, int ldsrc, const float* gain, int k0, bf16_t* dst, int K, LAS float* scr, int lane) {
    float v[32];
    if (src) { const float* sp = src + (size_t)(k0 + (lane >> 5)) * ldsrc + (lane & 31);
#pragma unroll
        for (int i = 0; i < 32; ++i) v[i] = sp[(size_t)(2 * i) * ldsrc];
    } else {
#pragma unroll
        for (int i = 0; i < 32; ++i) v[i] = 0.f;
    }
#pragma unroll
    for (int i = 0; i < 32; ++i) scr[(2 * i + (lane >> 5)) * 33 + (lane & 31)] = v[i];
    asm volatile("s_waitcnt lgkmcnt(0)" ::: "memory");
    const int c = lane & 7;
    f32x4 g0 = (f32x4){1.f, 1.f, 1.f, 1.f}, g1 = g0;
    if (gain) { g0 = *(const f32x4*)(gain + k0 + 8 * c); g1 = *(const f32x4*)(gain + k0 + 8 * c + 4); }
#pragma unroll
    for (int j = 0; j < 4; ++j) { const int n = (lane >> 3) + 8 * j; const LAS float* t = scr + (8 * c) * 33 + n;
        u32x4 o; o.x = pkbf(t[0 * 33] * g0[0], t[1 * 33] * g0[1]); o.y = pkbf(t[2 * 33] * g0[2], t[3 * 33] * g0[3]); o.z = pkbf(t[4 * 33] * g1[0], t[5 * 33] * g1[1]); o.w = pkbf(t[6 * 33] * g1[2], t[7 * 33] * g1[3]);
        *(u32x4*)(dst + (size_t)n * K + k0 + 8 * c) = o; }
    asm volatile("s_waitcnt lgkmcnt(0)" ::: "memory");
}
__device__ __forceinline__ int zcol_of_block(int nb) {
    const int tile = nb >> 3, q = nb & 7;
    switch (tile) {
        case 0: return 32 * nb;
        case 1: return q < 4 ? 256 + 32 * q : (q == 4 ? 640 : -1);
        case 2: return 384 + 32 * q;
        case 3: return 672 + 32 * q;
        case 4: return 928 + 64 * (q & 3) + 32 * (q >> 2);
        case 5: return q < 4 ? 1440 + 32 * q : 1696 + 32 * (q - 4);
        case 6: return q < 4 ? 1568 + 32 * q : 1824 + 32 * (q - 4);
        default: return 1184 + 32 * q;
    }
}
constexpr int IT_IN = 64 * 16, IT_UQ = 24 * 6, IT_UKV = 32 * 4, IT_OUT = 32 * 16, IT_GU = 176 * 16, IT_DN = 32 * 44, IT_LAYER = IT_IN + IT_UQ + IT_UKV + IT_OUT + IT_GU + IT_DN;

__device__ __forceinline__ void p0_prologue(const Params& P, LAS unsigned char* lds) {
    const int tid = TID_OPQ(), lane = tid & 63, wid = tid >> 6;
    const int gw = blockIdx.x * NWAVES + wid, NGW = gridDim.x * NWAVES;
    LAS float* scr = (LAS float*)(lds + wid * 16384);
    bf16_t* W = (bf16_t*)(P.ws + WS_W);
    for (int it = gw; it < IT_LAYER * DEPTH; it += NGW) {
        const int l = it / IT_LAYER; int r = it - l * IT_LAYER; bf16_t* Wl = W + (size_t)l * WE_LAYER;
        if (r < IT_IN) { const int nb = r >> 4, kb = r & 15, zc = zcol_of_block(nb);
            conv_item(zc >= 0 ? P.w_in + (size_t)l * DM * INW + zc : nullptr, INW, P.mix_pre_g + l * DM, 64 * kb, Wl + WE_IN + (size_t)(32 * nb) * DM, DM, scr, lane); continue; } r -= IT_IN;
        if (r < IT_UQ) { const int nb = r / 6, kb = r - 6 * nb;
            conv_item(P.w_uq + (size_t)l * QR * 768 + 32 * nb, 768, P.q_norm_g + l * QR, 64 * kb, Wl + WE_UQ + (size_t)(32 * nb) * QR, QR, scr, lane); continue; } r -= IT_UQ;
        if (r < IT_UKV) { const int nb = r >> 2, kb = r & 3;
            conv_item(P.w_ukv + (size_t)l * KVR * 1024 + 32 * nb, 1024, P.kv_norm_g + l * KVR, 64 * kb, Wl + WE_UKV + (size_t)(32 * nb) * KVR, KVR, scr, lane); continue; } r -= IT_UKV;
        if (r < IT_OUT) { const int nb = r >> 4, kb = r & 15;
            conv_item(P.w_out + (size_t)l * DM * DM + 32 * nb, DM, P.out_norm_g + l * DM, 64 * kb, Wl + WE_OUT + (size_t)(32 * nb) * DM, DM, scr, lane); continue; } r -= IT_OUT;
        if (r < IT_GU) { const int nb = r >> 4, kb = r & 15, tile = nb >> 3, q = nb & 7;
            const float* src = (q < 4 ? P.w_gate : P.w_up) + (size_t)l * DM * DFF + 128 * tile + 32 * (q & 3);
            conv_item(src, DFF, P.ffn_pre_g + l * DM, 64 * kb, Wl + WE_GU + (size_t)(32 * nb) * DM, DM, scr, lane); continue; } r -= IT_GU;
        { const int nb = r / 44, kb = r - 44 * nb;
            conv_item(P.w_down + (size_t)l * DFF * DM + 32 * nb, DM, nullptr, 64 * kb, Wl + WE_DN + (size_t)(32 * nb) * DFF, DFF, scr, lane); }
    }
    const int gt = blockIdx.x * NTHR + tid, NGT = gridDim.x * NTHR;
    for (int i = gt; i < DEPTH * 4 * 128 * 128; i += NGT) { const int l = i >> 16, rem = i & 65535, t = (rem >> 7) & 127, s = rem & 127;
        W[(size_t)l * WE_LAYER + WE_WC + rem] = (s <= t) ? f2bf(P.w_sp[i]) : (bf16_t)0; }
    float* CS = (float*)(P.ws + WS_CS);
    for (int i = gt; i < TT * 16; i += NGT) { const int row = i >> 4, k = i & 15; const double rev = (double)P.pos[row] * P.inv_rev[k]; const float fr = (float)(rev - rint(rev));
        CS[(size_t)row * 32 + k] = __builtin_amdgcn_cosf(fr); CS[(size_t)row * 32 + 16 + k] = __builtin_amdgcn_sinf(fr); }
    bf16_t* H = (bf16_t*)(P.ws + WS_H); float* RSp = (float*)(P.ws + WS_RS);
    for (int row = 2 * gw; row < TT; row += 2 * NGW) { f32x4 v[2][4]; float ssq[2];
#pragma unroll
        for (int i = 0; i < 2; ++i) { const float* xr = P.x + (size_t)(row + i) * DM + 4 * lane;
#pragma unroll
            for (int j = 0; j < 4; ++j) v[i][j] = *(const f32x4*)(xr + 256 * j); }
#pragma unroll
        for (int i = 0; i < 2; ++i) ssq[i] = (dot4(v[i][0]) + dot4(v[i][1])) + (dot4(v[i][2]) + dot4(v[i][3]));
#pragma unroll
        for (int o = 1; o < 64; o <<= 1) { ssq[0] += __shfl_xor(ssq[0], o); ssq[1] += __shfl_xor(ssq[1], o); }
#pragma unroll
        for (int i = 0; i < 2; ++i) { if (lane == 0) RSp[row + i] = 1.f / sqrtf(ssq[i] * (1.f / DM) + EPS);
#pragma unroll
            for (int j = 0; j < 4; ++j) store4(H + (size_t)(row + i) * DM + 4 * lane + 256 * j, v[i][j]); } }
}

__device__ __forceinline__ void resid_phase(bf16_t* XB, const bf16_t* F, const float* SS, const float* gpost, float* RS, float* outf) {
    const int tid = TID_OPQ(), lane = tid & 63, wid = tid >> 6;
    const int gw = blockIdx.x * NWAVES + wid, NGW = gridDim.x * NWAVES;
    f32x4 g4[4];
#pragma unroll
    for (int j = 0; j < 4; ++j) g4[j] = *(const f32x4*)(gpost + 4 * lane + 256 * j);
    for (int row = 2 * gw; row < TT; row += 2 * NGW) {
        f32x4 v[2][4], f[2][4]; float rs[2], s2[2];
#pragma unroll
        for (int i = 0; i < 2; ++i) { const float* sp = SS + (size_t)(row + i) * 16;
            rs[i] = (sum4(*(const f32x4*)sp) + sum4(*(const f32x4*)(sp + 4))) + (sum4(*(const f32x4*)(sp + 8)) + sum4(*(const f32x4*)(sp + 12)));
#pragma unroll
            for (int j = 0; j < 4; ++j) { const size_t o = (size_t)(row + i) * DM + 4 * lane + 256 * j; v[i][j] = load4bf(XB + o); f[i][j] = load4bf(F + o); } }
#pragma unroll
        for (int i = 0; i < 2; ++i) { const float r = 1.f / sqrtf(rs[i] * (1.f / DM) + EPS); s2[i] = 0.f;
#pragma unroll
            for (int j = 0; j < 4; ++j) { v[i][j] = v[i][j] + f[i][j] * r * g4[j]; s2[i] += dot4(v[i][j]); } }
        if (outf) {
#pragma unroll
            for (int i = 0; i < 2; ++i)
#pragma unroll
                for (int j = 0; j < 4; ++j) *(f32x4*)(outf + (size_t)(row + i) * DM + 4 * lane + 256 * j) = v[i][j];
        } else {
#pragma unroll
            for (int i = 0; i < 2; ++i)
#pragma unroll
                for (int j = 0; j < 4; ++j) store4(XB + (size_t)(row + i) * DM + 4 * lane + 256 * j, v[i][j]);
#pragma unroll
            for (int o = 1; o < 64; o <<= 1) { s2[0] += __shfl_xor(s2[0], o); s2[1] += __shfl_xor(s2[1], o); }
            if (lane < 2) RS[row + lane] = 1.f / sqrtf((lane == 0 ? s2[0] : s2[1]) * (1.f / DM) + EPS);
        }
    }
}

constexpr int KSTR = 208, VSTR = 136, KBUF = 64 * KSTR, VBUF = 64 * VSTR;
constexpr int LDS_K0 = 0, LDS_V0 = 2 * KBUF;
#define MFMA32(a, b, c) __builtin_amdgcn_mfma_f32_32x32x16_bf16((a), (b), (c), 0, 0, 0)
__device__ __forceinline__ float max3f(float a, float b, float c) { float r; asm("v_max3_f32 %0, %1, %2, %3" : "=v"(r) : "v"(a), "v"(b), "v"(c)); return r; }
typedef float f32x2 __attribute__((ext_vector_type(2)));

__device__ __forceinline__ void attn_unit(LAS unsigned char* lds, int bh, int qb, const bf16_t* Qf, const bf16_t* Kf, const bf16_t* Vt, bf16_t* MIX, float* SSA) {
    const int tid = TID_OPQ(), lane = tid & 63, wid = __builtin_amdgcn_readfirstlane(tid >> 6), r32 = lane & 31, hi = lane >> 5;
    const bf16_t* Kh = Kf + (size_t)bh * SEQ * 96; const bf16_t* Vh = Vt + (size_t)bh * 64 * SEQ; const bf16_t* Qh = Qf + (size_t)bh * SEQ * 96;
    const int q0 = qb * 256, NT = 4 * qb + 4;
    bf16x8 qf[6];
    { const bf16_t* qp = Qh + (size_t)(q0 + 32 * wid + r32) * 96 + 8 * hi;
#pragma unroll
      for (int ks = 0; ks < 6; ++ks) qf[ks] = *(const bf16x8*)(qp + 16 * ks); }
    const int kr0 = tid / 12, kc0 = tid - 12 * kr0, i1 = 512 + tid, kr1 = i1 / 12, kc1 = i1 - 12 * kr1;
    const int kl0 = kr0 * KSTR + kc0 * 16, kl1 = kr1 * KSTR + kc1 * 16;
    const int vl = (tid >> 3) * VSTR + (tid & 7) * 16;
    const bf16_t* kg = Kh + (size_t)tid * 8; const bf16_t* vg = Vh + (size_t)(tid >> 3) * SEQ + (tid & 7) * 8;
    u32x4 kreg0, kreg1 = (u32x4){0u, 0u, 0u, 0u}, vreg;
#define ATT_LOAD(t) do { kreg0 = *(const u32x4*)(kg + (size_t)(t) * 64 * 96); if (tid < 256) kreg1 = *(const u32x4*)(kg + (size_t)(t) * 64 * 96 + 512 * 8); vreg = *(const u32x4*)(vg + (t) * 64); } while (0)
#define ATT_STORE(buf) do { *(LAS u32x4*)(lds + LDS_K0 + (buf) * KBUF + kl0) = kreg0; if (tid < 256) *(LAS u32x4*)(lds + LDS_K0 + (buf) * KBUF + kl1) = kreg1; \
        *(LAS u32x2*)(lds + LDS_V0 + (buf) * VBUF + vl) = (u32x2){vreg.x, vreg.y}; *(LAS u32x2*)(lds + LDS_V0 + (buf) * VBUF + vl + 8) = (u32x2){vreg.z, vreg.w}; } while (0)
    f32x16 o0, o1;
#pragma unroll
    for (int r = 0; r < 16; ++r) { o0[r] = 0.f; o1[r] = 0.f; }
    float mrun = 0.f, lrun = 0.f;
    f32x16 negm;
#pragma unroll
    for (int r = 0; r < 16; ++r) negm[r] = 0.f;
    const int qrel = 32 * wid + r32;
    ATT_LOAD(0); ATT_STORE(0); __syncthreads();
    for (int t = 0; t < NT; ++t) {
        const int buf = t & 1;
        if (t + 1 < NT) ATT_LOAD(t + 1);
        const int jb = t - (NT - 4);
        if (jb <= (wid >> 1)) {
            f32x16 p0, p1;
            const LAS unsigned char* kb = lds + LDS_K0 + buf * KBUF + r32 * KSTR + 16 * hi;
            const LAS unsigned char* vb = lds + LDS_V0 + buf * VBUF + r32 * VSTR + 8 * hi;
            bf16x8 kf0[6], kf1[6]; u32x2 va_lo[4], va_hi[4], vb_lo[4], vb_hi[4];
#pragma unroll
            for (int ks = 0; ks < 6; ++ks) { kf0[ks] = *(const LAS bf16x8*)(kb + 32 * ks); kf1[ks] = *(const LAS bf16x8*)(kb + 32 * KSTR + 32 * ks); }
#pragma unroll
            for (int i = 0; i < 4; ++i) { const int off = 32 * i;
                va_lo[i] = *(const LAS u32x2*)(vb + off); va_hi[i] = *(const LAS u32x2*)(vb + off + 16);
                vb_lo[i] = *(const LAS u32x2*)(vb + 32 * VSTR + off); vb_hi[i] = *(const LAS u32x2*)(vb + 32 * VSTR + off + 16); }
            __builtin_amdgcn_sched_barrier(0);
#pragma unroll
            for (int ks = 0; ks < 6; ++ks) {
                if (ks == 0) { p0 = MFMA32(kf0[0], qf[0], negm); p1 = MFMA32(kf1[0], qf[0], negm); }
                else { p0 = MFMA32(kf0[ks], qf[ks], p0); p1 = MFMA32(kf1[ks], qf[ks], p1); } }
            if (jb >= 0) {
#pragma unroll
                for (int r = 0; r < 16; ++r) { const int kv = 64 * jb + crow(r, hi); if (kv > qrel) p0[r] = -1e30f; if (kv + 32 > qrel) p1[r] = -1e30f; }
            }
            float ma = max3f(p0[0], p0[1], p1[0]), mb = max3f(p0[2], p0[3], p1[1]); ma = max3f(ma, p1[2], p1[3]);
#pragma unroll
            for (int r = 4; r < 16; r += 4) { ma = max3f(ma, p0[r], p0[r + 1]); mb = max3f(mb, p0[r + 2], p0[r + 3]); ma = max3f(ma, p1[r], p1[r + 1]); mb = max3f(mb, p1[r + 2], p1[r + 3]); }
            float mx = fmaxf(ma, mb);
            mx = fmaxf(mx, __shfl_xor(mx, 32));
            if (t == 0 || __any(mx > 0.f)) {
                const float dl = (t == 0) ? mx : fmaxf(mx, 0.f), alpha = __builtin_amdgcn_exp2f(-dl); mrun += dl; lrun *= alpha;
#pragma unroll
                for (int r = 0; r < 16; ++r) { p0[r] -= dl; p1[r] -= dl; o0[r] *= alpha; o1[r] *= alpha; negm[r] = -mrun; }
            }
            f32x2 ls2 = (f32x2){0.f, 0.f};
#pragma unroll
            for (int r = 0; r < 16; ++r) { p0[r] = __builtin_amdgcn_exp2f(p0[r]); p1[r] = __builtin_amdgcn_exp2f(p1[r]); }
#pragma unroll
            for (int r = 0; r < 16; r += 2) { ls2 += (f32x2){p0[r], p0[r + 1]}; ls2 += (f32x2){p1[r], p1[r + 1]}; }
            lrun += ls2.x + ls2.y;
            bf16x8 pf[4];
#pragma unroll
            for (int s = 0; s < 2; ++s) { u32x4 w0, w1;
                w0.x = pkbf(p0[8 * s], p0[8 * s + 1]); w0.y = pkbf(p0[8 * s + 2], p0[8 * s + 3]); w0.z = pkbf(p0[8 * s + 4], p0[8 * s + 5]); w0.w = pkbf(p0[8 * s + 6], p0[8 * s + 7]);
                w1.x = pkbf(p1[8 * s], p1[8 * s + 1]); w1.y = pkbf(p1[8 * s + 2], p1[8 * s + 3]); w1.z = pkbf(p1[8 * s + 4], p1[8 * s + 5]); w1.w = pkbf(p1[8 * s + 6], p1[8 * s + 7]);
                pf[s] = __builtin_bit_cast(bf16x8, w0); pf[2 + s] = __builtin_bit_cast(bf16x8, w1); }
#pragma unroll
            for (int i = 0; i < 4; ++i) {
                const bf16x8 va = __builtin_bit_cast(bf16x8, (u32x4){va_lo[i].x, va_lo[i].y, va_hi[i].x, va_hi[i].y}), vbb = __builtin_bit_cast(bf16x8, (u32x4){vb_lo[i].x, vb_lo[i].y, vb_hi[i].x, vb_hi[i].y});
                o0 = MFMA32(va, pf[i], o0); o1 = MFMA32(vbb, pf[i], o1); }
        }
        if (t + 1 < NT) ATT_STORE(buf ^ 1);
        __syncthreads();
    }
#undef ATT_LOAD
#undef ATT_STORE
    const float ltot = lrun + __shfl_xor(lrun, 32), inv = 1.f / ltot;
    float ss = 0.f;
#pragma unroll
    for (int r = 0; r < 16; ++r) { o0[r] *= inv; o1[r] *= inv; ss += o0[r] * o0[r] + o1[r] * o1[r]; }
    ss += __shfl_xor(ss, 32);
    const int b = bh >> 3, h = bh & 7; const size_t row = (size_t)b * SEQ + q0 + 32 * wid + r32;
    if (hi == 0) SSA[row * 16 + h] = ss;
    bf16_t* op = MIX + row * DM + h * 64 + 4 * hi;
#pragma unroll
    for (int g4 = 0; g4 < 4; ++g4) { store4(op + 8 * g4, (f32x4){o0[4 * g4], o0[4 * g4 + 1], o0[4 * g4 + 2], o0[4 * g4 + 3]});
        store4(op + 32 + 8 * g4, (f32x4){o1[4 * g4], o1[4 * g4 + 1], o1[4 * g4 + 2], o1[4 * g4 + 3]}); }
}
__device__ __forceinline__ void attn_phase(LAS unsigned char* lds, const bf16_t* Qf, const bf16_t* Kf, const bf16_t* Vt, bf16_t* MIX, float* SSA) {
    const int G = gridDim.x, bx = blockIdx.x; const int vcu = (G % 8 == 0) ? (bx % 8) * (G / 8) + bx / 8 : bx;
    for (int w = vcu; w < 256; w += G) { const int bh = w >> 2, s4 = w & 3;
#pragma unroll 1
        for (int i = 0; i < 4; ++i) { const int qb = (i == 0) ? 15 - s4 : (i == 1) ? 8 + s4 : (i == 2) ? 7 - s4 : s4; attn_unit(lds, bh, qb, Qf, Kf, Vt, MIX, SSA); } }
}

__device__ __forceinline__ void sgu_unit(LAS unsigned char* lds, int chunk, const bf16_t* VNT, const bf16_t* WC, const float* bsp, const bf16_t* U, const float* SSA, bf16_t* MIX) {
    const int tid = TID_OPQ(), lane = tid & 63, wid = __builtin_amdgcn_readfirstlane(tid >> 6), r32 = lane & 31, hi = lane >> 5;
    const int g = wid >> 1, th = wid & 1;
    LAS float* red = (LAS float*)lds;
    const bf16_t* ap = VNT + ((size_t)(chunk * 4 + g) * 64 + r32) * 128 + 8 * hi;
    const bf16_t* bp = WC + ((size_t)g * 128 + 64 * th + r32) * 128 + 8 * hi;
    f32x16 acc[2][2];
#pragma unroll
    for (int a = 0; a < 2; ++a)
#pragma unroll
        for (int b = 0; b < 2; ++b)
#pragma unroll
            for (int r = 0; r < 16; ++r) acc[a][b][r] = 0.f;
#pragma unroll
    for (int ks = 0; ks < 8; ++ks) {
        const bf16x8 a0 = *(const bf16x8*)(ap + 16 * ks), a1 = *(const bf16x8*)(ap + 32 * 128 + 16 * ks);
        const bf16x8 b0 = *(const bf16x8*)(bp + 16 * ks), b1 = *(const bf16x8*)(bp + 32 * 128 + 16 * ks);
        acc[0][0] = MFMA32(a0, b0, acc[0][0]); acc[0][1] = MFMA32(a0, b1, acc[0][1]); acc[1][0] = MFMA32(a1, b0, acc[1][0]); acc[1][1] = MFMA32(a1, b1, acc[1][1]);
    }
#pragma unroll
    for (int tb = 0; tb < 2; ++tb) { const int t = 64 * th + 32 * tb + r32; const size_t row = (size_t)chunk * 128 + t; const float bias = bsp[g * 128 + t]; float ss = 0.f;
#pragma unroll
        for (int eb = 0; eb < 2; ++eb)
#pragma unroll
            for (int g4 = 0; g4 < 4; ++g4) { const f32x4 uu = load4bf(U + row * 256 + g * 64 + 32 * eb + 8 * g4 + 4 * hi);
#pragma unroll
                for (int j = 0; j < 4; ++j) { const float v = uu[j] * (acc[eb][tb][4 * g4 + j] + bias); acc[eb][tb][4 * g4 + j] = v; ss += v * v; } }
        ss += __shfl_xor(ss, 32);
        if (hi == 0) red[g * 128 + t] = ss; }
    __syncthreads();
#pragma unroll
    for (int tb = 0; tb < 2; ++tb) { const int t = 64 * th + 32 * tb + r32; const size_t row = (size_t)chunk * 128 + t;
        const float* sa = SSA + row * 16; const float rai = sqrtf((sum4(*(const f32x4*)sa) + sum4(*(const f32x4*)(sa + 4))) * (1.f / 512.f) + EPS);
        const float tot = (red[t] + red[128 + t]) + (red[256 + t] + red[384 + t]); const float rs = rai / sqrtf(tot * (1.f / 256.f) + EPS);
#pragma unroll
        for (int eb = 0; eb < 2; ++eb)
#pragma unroll
            for (int g4 = 0; g4 < 4; ++g4) store4(MIX + row * DM + 512 + g * 64 + 32 * eb + 8 * g4 + 4 * hi,
                (f32x4){acc[eb][tb][4 * g4] * rs, acc[eb][tb][4 * g4 + 1] * rs, acc[eb][tb][4 * g4 + 2] * rs, acc[eb][tb][4 * g4 + 3] * rs}); }
    __syncthreads();
}
__device__ __forceinline__ void light_phase(LAS unsigned char* lds, const bf16_t* VNT, const bf16_t* WC, const float* bsp, const bf16_t* U, const bf16_t* Y, const bf16_t* GB,
                                            const float* cw, const float* SSA, bf16_t* MIX) {
    for (int c = blockIdx.x; c < TT / 128; c += gridDim.x) sgu_unit(lds, c, VNT, WC, bsp, U, SSA, MIX);
    const int tid = TID_OPQ(), lane = tid & 63, wid = tid >> 6;
    const int gw = blockIdx.x * NWAVES + wid, NGW = gridDim.x * NWAVES;
    const f32x4 w0 = *(const f32x4*)(cw + 4 * lane), w1 = *(const f32x4*)(cw + 256 + 4 * lane), w2 = *(const f32x4*)(cw + 512 + 4 * lane);
    for (int r0 = 8 * gw; r0 < TT; r0 += 8 * NGW) { const bool first = (r0 & 4095) == 0; f32x4 y[10], gb[8], yc[8]; float ss[8];
        y[0] = first ? (f32x4){0.f, 0.f, 0.f, 0.f} : load4bf(Y + (size_t)(r0 - 2) * 256 + 4 * lane);
        y[1] = first ? (f32x4){0.f, 0.f, 0.f, 0.f} : load4bf(Y + (size_t)(r0 - 1) * 256 + 4 * lane);
#pragma unroll
        for (int i = 0; i < 8; ++i) { y[i + 2] = load4bf(Y + (size_t)(r0 + i) * 256 + 4 * lane); gb[i] = load4bf(GB + (size_t)(r0 + i) * 256 + 4 * lane); }
#pragma unroll
        for (int i = 0; i < 8; ++i) { yc[i] = gb[i] * (y[i] * w0 + y[i + 1] * w1 + y[i + 2] * w2); ss[i] = dot4(yc[i]); }
#pragma unroll
        for (int o = 1; o < 64; o <<= 1) {
#pragma unroll
            for (int i = 0; i < 8; ++i) ss[i] += __shfl_xor(ss[i], o); }
#pragma unroll
        for (int i = 0; i < 8; ++i) { const float* sa = SSA + (size_t)(r0 + i) * 16; const float rai = sqrtf((sum4(*(const f32x4*)sa) + sum4(*(const f32x4*)(sa + 4))) * (1.f / 512.f) + EPS);
            store4(MIX + (size_t)(r0 + i) * DM + 768 + 4 * lane, yc[i] * (rai / sqrtf(ss[i] * (1.f / 256.f) + EPS))); } }
}

#define XB_TMO      128
#define XB_XCNT(j)  (256  + 64 * (j))
#define XB_XSUB(j)  (1280 + 64 * (j))
#define XB_XGEN(j)  (2304 + 64 * (j))
#define XB_TOP      3328
#define XB_TOPGEN   3392
#define XCD_BAR_WORDS 3456
#define XB_SPIN_CAP (1u << 18)

__device__ __forceinline__ unsigned xb_ld(unsigned* p)              { return __hip_atomic_load(p, __ATOMIC_RELAXED, __HIP_MEMORY_SCOPE_AGENT); }
__device__ __forceinline__ unsigned xb_add(unsigned* p, unsigned v) { return __hip_atomic_fetch_add(p, v, __ATOMIC_RELAXED, __HIP_MEMORY_SCOPE_AGENT); }
__device__ __forceinline__ unsigned xb_xcc_id() { return (unsigned)__builtin_amdgcn_s_getreg((3 << 11) | 20) & 0xFu; }
#define XB_SPIN(cond, bar) do { unsigned _sp = 0; while (cond) { __builtin_amdgcn_s_sleep(1); \
    if ((++_sp & 255u) == 0u) { if (xb_ld(&(bar)[XB_TMO])) break; if (_sp > XB_SPIN_CAP) { atomicAdd(&(bar)[XB_TMO], 1u); break; } } } } while (0)

struct XcdBarrier {
    unsigned* bar; unsigned x;
    volatile LAS unsigned* st;
};

__device__ __forceinline__ XcdBarrier xcd_barrier_post(unsigned* bar, volatile LAS unsigned* st) {
    XcdBarrier b; b.bar = bar; b.x = xb_xcc_id(); b.st = st;
    if (threadIdx.x == 0) (void)xb_add(&bar[XB_XCNT(b.x)], 1u);
    return b;
}
__device__ __forceinline__ void xcd_barrier_complete(unsigned* bar, unsigned x, unsigned& nloc, unsigned& nx) {
    const unsigned G = gridDim.x * gridDim.y * gridDim.z;
    unsigned sum, cnt, mine, sp = 0u;
    for (;;) {
        sum = 0u; cnt = 0u; mine = 0u;
#pragma unroll
        for (unsigned j = 0; j < 16; ++j) { const unsigned c = xb_ld(&bar[XB_XCNT(j)]); sum += c; cnt += (c > 0u) ? 1u : 0u; mine = (j == x) ? c : mine; }
        if (sum == G) break;
        __builtin_amdgcn_s_sleep(1);
        if ((++sp & 255u) == 0u) { if (xb_ld(&bar[XB_TMO])) break; if (sp > XB_SPIN_CAP) { atomicAdd(&bar[XB_TMO], 1u); break; } }
    }
    nloc = mine > 0u ? mine : 1u; nx = cnt > 0u ? cnt : 1u;
}

__device__ __forceinline__ void xcd_barrier(const XcdBarrier& b) {
    asm volatile("s_waitcnt vmcnt(0)" ::: "memory");
    __syncthreads();
    if (threadIdx.x == 0) {
        unsigned* bar = b.bar;
        __builtin_amdgcn_s_waitcnt(0);
        unsigned nloc = b.st[0], nx = b.st[1];
        if (nloc == 0u) { xcd_barrier_complete(bar, b.x, nloc, nx); b.st[0] = nloc; b.st[1] = nx; }
        const unsigned old = xb_add(&bar[XB_XSUB(b.x)], 1u);
        const unsigned gen = old / nloc;
        if (old + 1u == (gen + 1u) * nloc) {
            __builtin_amdgcn_fence(__ATOMIC_RELEASE, "agent");
            asm volatile("s_waitcnt vmcnt(0)" ::: "memory");
            const unsigned og = xb_add(&bar[XB_TOP], 1u);
            const unsigned tg = og / nx;
            if (og + 1u == (tg + 1u) * nx) xb_add(&bar[XB_TOPGEN], 1u);
            else XB_SPIN(xb_ld(&bar[XB_TOPGEN]) == tg, bar);
            __builtin_amdgcn_fence(__ATOMIC_ACQUIRE, "agent");
            xb_add(&bar[XB_XGEN(b.x)], 1u);
            asm volatile("s_waitcnt vmcnt(0)" ::: "memory");
        } else {
            XB_SPIN(xb_ld(&bar[XB_XGEN(b.x)]) == gen, bar);
            __builtin_amdgcn_fence(__ATOMIC_ACQUIRE, "agent");
            asm volatile("s_waitcnt vmcnt(0)" ::: "memory");
        }
    }
    __syncthreads();
}

#ifndef REP_SYNC
#define REP_SYNC 1
#endif
#define GSYNC() do { for (int rs_ = 0; rs_ < REP_SYNC; ++rs_) xcd_barrier(xbar); } while (0)
#ifndef REP_P0
#define REP_P0 1
#endif
#ifndef REP_R0
#define REP_R0 1
#endif
#ifndef REP_G1
#define REP_G1 1
#endif
#ifndef REP_G2
#define REP_G2 1
#endif
#ifndef REP_LIGHT
#define REP_LIGHT 1
#endif
#ifndef REP_ATT
#define REP_ATT 1
#endif
#ifndef REP_GEMM
#define REP_GEMM 1
#endif
#define GEMM_PHASE(EPI, Aptr, Bptr, Mv, Nv, Kv, Eobj) for (int rep_ = 0; rep_ < REP_GEMM; ++rep_) do { int k_ = (Kv); asm volatile("" : "+s"(k_)); pg8::Gemm g_{(const pg8::bf16_t*)(Aptr), (const pg8::bf16_t*)(Bptr), (Mv), (Nv), k_}; pg8::StaticOrder S_; S_.init((Mv), (Nv), (int)gridDim.x, (int)blockIdx.x); \
        pg8::gemm_phase<EPI, pg8::StaticOrder, true, true>(lds, g_, S_, (Eobj)); } while (0)


__device__ __forceinline__ unsigned char* opq_ws(unsigned char* p) { asm volatile("" : "+s"(p)); return p; }
#define WSP(T, off) ((T*)(opq_ws(P.ws) + (off)))
#define W_ WSP(bf16_t, WS_W)
#define CS_ WSP(float, WS_CS)
#define SSQ_ WSP(float, WS_SS)
#define SSKV_ WSP(float, WS_SS + SS_STRIDE)
#define SSA_ WSP(float, WS_SS + 2 * SS_STRIDE)
#define SSF_ WSP(float, WS_SS + 3 * SS_STRIDE)
#define SSF2_ WSP(float, WS_SS + 4 * SS_STRIDE)
#define H_ WSP(bf16_t, WS_H)
#define CQ_ WSP(bf16_t, R_CQ)
#define CKV_ WSP(bf16_t, R_CKV)
#define U_ WSP(bf16_t, R_U)
#define VNT_ WSP(bf16_t, R_VNT)
#define Y_ WSP(bf16_t, R_Y)
#define GB_ WSP(bf16_t, R_GB)
#define QF_ WSP(bf16_t, R_QF)
#define KF_ WSP(bf16_t, R_KF)
#define VT_ WSP(bf16_t, R_VT)
#define MIX_ WSP(bf16_t, R_MIX)
#define F_ WSP(bf16_t, R_F)
#define HMID_ WSP(bf16_t, R_HMID)
#define F2_ WSP(bf16_t, R_F2)
__global__ void __launch_bounds__(NTHR, 2) fwd_kernel(Params P) {
    extern __shared__ __attribute__((aligned(16))) unsigned char lds_raw[];
    LAS unsigned char* lds = (LAS unsigned char*)lds_raw;
    cg::grid_group grid = cg::this_grid();
    volatile LAS unsigned* xst = (volatile LAS unsigned*)(lds + 131072 + 128);
    if (threadIdx.x < 2) xst[threadIdx.x] = 0u;
    __syncthreads();
    const XcdBarrier xbar = xcd_barrier_post((unsigned*)(P.ws + WS_CTL), xst);
#ifndef PHMASK
#define PHMASK 0xFFFF
#endif
    if (PHMASK & 1) for (int rp_ = 0; rp_ < REP_P0; ++rp_) p0_prologue(P, lds);
    grid.sync();
#pragma unroll 1
    for (int l = 0; l < DEPTH; ++l) {
        const size_t wl = (size_t)l * WE_LAYER;
        for (int r1_ = 0; r1_ < REP_G1; ++r1_)
        if (PHMASK & 2) { EpiA E{opq_ws(P.ws), P.sg_ln_g + l * 256, P.sg_ln_b + l * 256};
          GEMM_PHASE(EpiA, H_, W_ + wl + WE_IN, TT, INP, DM, E); }
        GSYNC();
        for (int r2_ = 0; r2_ < REP_G2; ++r2_) {
        if (PHMASK & 4) { EpiQ E{QF_, SSQ_, CS_}; GEMM_PHASE(EpiQ, CQ_, W_ + wl + WE_UQ, TT, 768, QR, E); }
        if (PHMASK & 8) { EpiKV E{KF_, VT_, SSKV_}; GEMM_PHASE(EpiKV, CKV_, W_ + wl + WE_UKV, TT, 1024, KVR, E); }
        }
        GSYNC();
        if (PHMASK & 16) for (int rep_ = 0; rep_ < REP_ATT; ++rep_) attn_phase(lds, QF_, KF_, VT_, MIX_, SSA_);
        GSYNC();
        for (int rl_ = 0; rl_ < REP_LIGHT; ++rl_) if (PHMASK & 32) light_phase(lds, VNT_, W_ + wl + WE_WC, P.b_sp + l * 512, U_, Y_, GB_, P.conv_w + l * 768, SSA_, MIX_);
        GSYNC();
        if (PHMASK & 64) { EpiF<true> E{F_, SSF_, SSA_}; GEMM_PHASE(EpiF<true>, MIX_, W_ + wl + WE_OUT, TT, DM, DM, E); }
        GSYNC();
        if (PHMASK & 128) resid_phase(H_, F_, SSF_, P.mix_post_g + l * DM, WSP(float, WS_RS), nullptr);
        GSYNC();
        if (PHMASK & 256) { EpiGU E{HMID_, WSP(float, WS_RS)}; GEMM_PHASE(EpiGU, H_, W_ + wl + WE_GU, TT, 2 * DFF, DM, E); }
        GSYNC();
        if (PHMASK & 512) { EpiF<false> E{F2_, SSF2_, nullptr}; GEMM_PHASE(EpiF<false>, HMID_, W_ + wl + WE_DN, TT, DM, DFF, E); }
        GSYNC();
        if (PHMASK & 1024) resid_phase(H_, F2_, SSF2_, P.ffn_post_g + l * DM, WSP(float, WS_RS), l + 1 < DEPTH ? nullptr : P.out);
        if (l + 1 < DEPTH) GSYNC();
    }
}

extern "C" void kernel_launch(void* const* d_in, const int* in_sizes, int n_in, void* d_out, int out_size, void* d_ws, size_t ws_size, hipStream_t stream) {
    static int grid = 0;
    if (grid == 0) {
        if (n_in != 21 || out_size != TT * DM || ws_size < WS_END) { fprintf(stderr, "kernel_launch: unexpected problem (n_in %d out %d ws %zu)\n", n_in, out_size, ws_size); grid = -1; return; }
        int dev = 0, cus = 0, per_cu = 0;
        hipGetDevice(&dev); hipDeviceGetAttribute(&cus, hipDeviceAttributeMultiprocessorCount, dev);
        if (hipFuncSetAttribute((const void*)fwd_kernel, hipFuncAttributeMaxDynamicSharedMemorySize, LDS_BYTES) != hipSuccess) { fprintf(stderr, "kernel_launch: hipFuncSetAttribute failed\n"); grid = -1; return; }
        if (hipOccupancyMaxActiveBlocksPerMultiprocessor(&per_cu, (const void*)fwd_kernel, NTHR, LDS_BYTES) != hipSuccess || per_cu < 1) { fprintf(stderr, "kernel_launch: occupancy query gave %d\n", per_cu); per_cu = 1; }
        (void)hipGetLastError();
        grid = cus;
    }
    if (grid < 0) return;
    Params p{};
    p.x = (const float*)d_in[0]; p.pos = (const int*)d_in[1];
    p.mix_pre_g = (const float*)d_in[2]; p.mix_post_g = (const float*)d_in[3]; p.ffn_pre_g = (const float*)d_in[4]; p.ffn_post_g = (const float*)d_in[5];
    p.w_in = (const float*)d_in[6]; p.q_norm_g = (const float*)d_in[7]; p.w_uq = (const float*)d_in[8]; p.kv_norm_g = (const float*)d_in[9]; p.w_ukv = (const float*)d_in[10];
    p.sg_ln_g = (const float*)d_in[11]; p.sg_ln_b = (const float*)d_in[12]; p.w_sp = (const float*)d_in[13]; p.b_sp = (const float*)d_in[14]; p.conv_w = (const float*)d_in[15];
    p.out_norm_g = (const float*)d_in[16]; p.w_out = (const float*)d_in[17]; p.w_gate = (const float*)d_in[18]; p.w_up = (const float*)d_in[19]; p.w_down = (const float*)d_in[20];
    p.out = (float*)d_out; p.ws = (unsigned char*)d_ws;
    for (int i = 0; i < 16; ++i) p.inv_rev[i] = pow(10000.0, -(double)i / 16.0) / 6.283185307179586476925;
    if (hipMemsetAsync((char*)d_ws + WS_CTL, 0, CTL_BYTES, stream) != hipSuccess) { fprintf(stderr, "kernel_launch: memset failed\n"); return; }
    void* args[] = {&p};
    hipError_t e = hipLaunchCooperativeKernel((const void*)fwd_kernel, dim3(grid), dim3(NTHR), args, LDS_BYTES, stream);
    if (e != hipSuccess) fprintf(stderr, "kernel_launch: cooperative launch failed: %s (grid %d)\n", hipGetErrorString(e), grid);
}
```
